# Optimizing an MI355X kernel written in HIP

```python
import jax
import jax.numpy as jnp
from jax import lax
import numpy as np

D_MODEL = 1024
BATCH = 8
SEQ = 2048
DEPTH = 1

CHUNK = 64
Q_BLOCK = 128
EPS = 1e-6
H_M = 4
W_M = D_MODEL // 2
DH_M = W_M // H_M
CONV_K = 4
H_F = 8
W_F = D_MODEL // 2
DH_F = W_F // H_F
D_FF = (8 * D_MODEL + 3 * 256 - 1) // (3 * 256) * 256
IN_SIZES = (W_M, W_M, W_M, W_M, H_M, H_M, W_F, W_F, W_F, H_F, D_MODEL, D_MODEL)
N_IN = sum(IN_SIZES)
MF_OFF = 4 * W_M + H_M
FF_OFF = 4 * W_M + 2 * H_M + 3 * W_F

kernel_name = "hybrid_mlstm_fox_block"


def rmsnorm(x, g):
    xf = x.astype(jnp.float32)
    y = xf * lax.rsqrt(jnp.mean(xf * xf, axis=-1, keepdims=True) + EPS)
    return (y * g.astype(jnp.float32)).astype(x.dtype)


def split_heads(t, n_heads):
    b, s, _ = t.shape
    return t.reshape(b, s, n_heads, -1).transpose(0, 2, 1, 3)


def merge_heads(t):
    b, h, s, d = t.shape
    return t.transpose(0, 2, 1, 3).reshape(b, s, h * d)


def causal_depthwise_conv(u, w, b):
    y = lax.conv_general_dilated(
        u, w[:, None, :].astype(u.dtype), window_strides=(1,),
        padding=[(CONV_K - 1, 0)], dimension_numbers=("NWC", "WIO", "NWC"),
        feature_group_count=u.shape[-1])
    return y + b.astype(u.dtype)


def mlstm_chunkwise(q, k, v, log_i, log_f):
    bsz, nh, s, d = q.shape
    nc = s // CHUNK

    def to_chunks(t):
        t = t.reshape(bsz, nh, nc, CHUNK, *t.shape[3:])
        return jnp.moveaxis(t, 2, 0)

    causal = jnp.tril(jnp.ones((CHUNK, CHUNK), dtype=bool))

    def step(carry, inp):
        c_mat, n_vec, m_prev = carry
        qc, kc, vc, ic, fc = inp
        b = jnp.cumsum(fc, axis=-1)
        log_d = jnp.where(causal, b[..., :, None] - b[..., None, :] + ic[..., None, :], -jnp.inf)
        m_inter = b + m_prev[..., None]
        m_t = jnp.maximum(m_inter, jnp.max(log_d, axis=-1))
        a = jnp.exp(m_inter - m_t)
        s_qk = jnp.einsum("bhtd,bhsd->bhts", qc, kc) * jnp.exp(log_d - m_t[..., None])
        num = a[..., None] * jnp.einsum("bhtk,bhkv->bhtv", qc, c_mat) + jnp.einsum("bhts,bhsv->bhtv", s_qk, vc)
        den = a * jnp.einsum("bhtk,bhk->bht", qc, n_vec) + jnp.sum(s_qk, axis=-1)
        h = num / jnp.maximum(jnp.abs(den), jnp.exp(-m_t))[..., None]
        b_last = b[..., -1]
        log_w = b_last[..., None] - b + ic
        m_new = jnp.maximum(b_last + m_prev, jnp.max(log_w, axis=-1))
        decay = jnp.exp(b_last + m_prev - m_new)
        w = jnp.exp(log_w - m_new[..., None])
        c_new = decay[..., None, None] * c_mat + jnp.einsum("bhs,bhsk,bhsv->bhkv", w, kc, vc)
        n_new = decay[..., None] * n_vec + jnp.einsum("bhs,bhsk->bhk", w, kc)
        return (c_new, n_new, m_new), h

    init = (jnp.zeros((bsz, nh, d, d), jnp.float32),
            jnp.zeros((bsz, nh, d), jnp.float32),
            jnp.zeros((bsz, nh), jnp.float32))
    _, hs = lax.scan(step, init, (to_chunks(q), to_chunks(k), to_chunks(v),
                                  to_chunks(log_i), to_chunks(log_f)))
    return jnp.moveaxis(hs, 0, 2).reshape(bsz, nh, s, d)


def forgetting_attention(q, k, v, log_f):
    s = q.shape[2]
    scale = q.shape[-1] ** -0.5
    cum = jnp.cumsum(log_f, axis=-1)
    outs = []
    for blk in range(s // Q_BLOCK):
        lo = blk * Q_BLOCK
        hi = lo + Q_BLOCK
        logits = (jnp.einsum("bhtd,bhsd->bhts", q[:, :, lo:hi], k[:, :, :hi]) * scale
                  + (cum[:, :, lo:hi, None] - cum[:, :, None, :hi]))
        mask = (lo + jnp.arange(Q_BLOCK))[:, None] >= jnp.arange(hi)[None, :]
        p = jax.nn.softmax(jnp.where(mask, logits, -jnp.inf), axis=-1)
        outs.append(jnp.einsum("bhts,bhsd->bhtd", p, v[:, :, :hi]))
    return jnp.concatenate(outs, axis=2)


def swiglu(h, w_gate, w_up, w_down):
    return (jax.nn.silu(h @ w_gate) * (h @ w_up)) @ w_down


def setup_inputs(seed: int = 0) -> dict:
    key = jax.random.key(seed)
    ks = jax.random.split(key, 16)

    def dense(k, shape, fan_in):
        return jax.random.normal(k, shape, jnp.float32) * fan_in ** -0.5

    def gain(k, shape):
        return 1.0 + 0.02 * jax.random.normal(k, shape, jnp.float32)

    x = jax.random.normal(ks[0], (BATCH, SEQ, D_MODEL), jnp.float32)
    norm1_g = gain(ks[1], (DEPTH, D_MODEL))
    w_in = dense(ks[2], (DEPTH, D_MODEL, N_IN), D_MODEL)
    b_in = 0.02 * jax.random.normal(ks[3], (DEPTH, N_IN), jnp.float32)
    b_in = b_in.at[:, MF_OFF:MF_OFF + H_M].add(jnp.linspace(3.0, 6.0, H_M))
    b_in = b_in.at[:, FF_OFF:FF_OFF + H_F].add(jnp.linspace(2.0, 6.0, H_F))
    conv_w = dense(ks[4], (DEPTH, CONV_K, 2 * W_M), CONV_K)
    conv_b = 0.02 * jax.random.normal(ks[5], (DEPTH, 2 * W_M), jnp.float32)
    mlstm_norm_g = gain(ks[6], (DEPTH, W_M))
    w_br_mlstm = dense(ks[7], (DEPTH, W_M, D_MODEL), W_M)
    w_br_fox = dense(ks[8], (DEPTH, W_F, D_MODEL), W_F)
    w_out = dense(ks[9], (DEPTH, D_MODEL, D_MODEL), D_MODEL)
    norm2_g = gain(ks[10], (DEPTH, D_MODEL))
    w_gate = dense(ks[11], (DEPTH, D_MODEL, D_FF), D_MODEL)
    w_up = dense(ks[12], (DEPTH, D_MODEL, D_FF), D_MODEL)
    w_down = dense(ks[13], (DEPTH, D_FF, D_MODEL), D_FF)
    norm_f_g = gain(ks[14], (D_MODEL,))
    return {"x": x, "norm1_g": norm1_g, "w_in": w_in, "b_in": b_in,
            "conv_w": conv_w, "conv_b": conv_b, "mlstm_norm_g": mlstm_norm_g,
            "w_br_mlstm": w_br_mlstm, "w_br_fox": w_br_fox, "w_out": w_out,
            "norm2_g": norm2_g, "w_gate": w_gate, "w_up": w_up, "w_down": w_down,
            "norm_f_g": norm_f_g}


def reference(x, norm1_g, w_in, b_in, conv_w, conv_b, mlstm_norm_g, w_br_mlstm,
              w_br_fox, w_out, norm2_g, w_gate, w_up, w_down, norm_f_g):
    f32 = jnp.float32
    split_points = np.cumsum(IN_SIZES)[:-1].tolist()
    for l in range(DEPTH):
        h = rmsnorm(x, norm1_g[l])
        z = h @ w_in[l] + b_in[l]
        mq, mk, mv, mo, mi, mf, fq, fk, fv, ff, gm, gf = jnp.split(z, split_points, axis=-1)

        qk = jax.nn.silu(causal_depthwise_conv(jnp.concatenate([mq, mk], axis=-1), conv_w[l], conv_b[l]))
        mq, mk = qk[..., :W_M], qk[..., W_M:]
        hm = mlstm_chunkwise(
            split_heads(mq, H_M).astype(f32),
            split_heads(mk, H_M).astype(f32) * DH_M ** -0.5,
            split_heads(mv, H_M).astype(f32),
            mi.astype(f32).transpose(0, 2, 1),
            jax.nn.log_sigmoid(mf.astype(f32)).transpose(0, 2, 1))
        hm = hm * lax.rsqrt(jnp.mean(hm * hm, axis=-1, keepdims=True) + EPS)
        y_m = (merge_heads(hm) * mlstm_norm_g[l].astype(f32)
               * jax.nn.sigmoid(mo.astype(f32))).astype(x.dtype)

        hf = forgetting_attention(
            split_heads(fq, H_F).astype(f32),
            split_heads(fk, H_F).astype(f32),
            split_heads(fv, H_F).astype(f32),
            jax.nn.log_sigmoid(ff.astype(f32)).transpose(0, 2, 1))
        y_f = merge_heads(hf).astype(x.dtype)

        mix = jax.nn.sigmoid(gm) * (y_m @ w_br_mlstm[l]) + jax.nn.sigmoid(gf) * (y_f @ w_br_fox[l])
        x = x + mix @ w_out[l]

        x = x + swiglu(rmsnorm(x, norm2_g[l]), w_gate[l], w_up[l], w_down[l])
    return rmsnorm(x, norm_f_g)
```

```cpp
#include <hip/hip_runtime.h>
#include <hip/hip_cooperative_groups.h>
#include <hip/hip_bf16.h>
#include <cstdio>
#include <cstdint>
#include <cmath>
namespace pg8 {
#define PG8_LAS __attribute__((address_space(3)))
typedef unsigned short bf16_t;
typedef short bf16x8 __attribute__((ext_vector_type(8)));
typedef float f32x4 __attribute__((ext_vector_type(4)));
typedef unsigned u32x4 __attribute__((ext_vector_type(4)));
constexpr int BM = 256, BK = 64, HALF = 128, HTB = HALF * BK * 2  , STAGE_BYTES = 8 * HTB, NXCD = 8, WGM = 8;

__host__ __device__ __forceinline__ int lds_byte(int r, int c) { const int st = (r >> 4) * 2 + (c >> 5), rr = r & 15, cc = c & 31, ob = rr * 64 + cc * 2; return st * 1024 + (ob ^ (((ob >> 9) & 1) << 5)); }
__host__ __device__ __forceinline__ void stage_rc(int b, int& R, int& C) { const int st = b / 1024, sb = b % 1024, swz = sb ^ (((sb >> 9) & 1) << 5); R = (st >> 1) * 16 + swz / 64; C = (st & 1) * 32 + (swz % 64) / 2; }
__host__ __device__ __forceinline__ int perm32(int rho) { const int n = rho >> 4, i = rho & 15; return 8 * (i >> 2) + 4 * n + (i & 3); }

struct Unit { int pm, pn; };
struct Gemm { const bf16_t* A; const bf16_t* Bt; int M, N, K; };

struct StaticOrder {
    int nM, nN, nwg, G, c;
    __host__ __device__ void init(int M, int N, int G_, int c_) { nM = M / BM; nN = N / BM; nwg = nM * nN; G = G_; c = c_; }
    __host__ __device__ bool next(int i, Unit& u) const {
        const long L = (long)i * G + c; if (L >= nwg) return false;
        int wgid = (int)L; { const int q = nwg / NXCD, r = nwg % NXCD, xcd = wgid % NXCD, off = wgid / NXCD; wgid = (xcd < r ? xcd * (q + 1) : r * (q + 1) + (xcd - r) * q) + off; }
        const int nig = WGM * nN, gid = wgid / nig, fm = gid * WGM, gsz = (nM - fm) < WGM ? (nM - fm) : WGM;
        u.pm = fm + ((wgid % nig) % gsz); u.pn = (wgid % nig) / gsz; return true;
    }
    __device__ __forceinline__ void a_ready(const Unit&) const {}
    __device__ __forceinline__ void done(const Unit&) const {}
};

__device__ __forceinline__ unsigned cvt_pk_bf16(float lo, float hi) { unsigned r; asm volatile("v_cvt_pk_bf16_f32 %0, %1, %2" : "=v"(r) : "v"(lo), "v"(hi)); return r; }
typedef float f32x2 __attribute__((ext_vector_type(2)));
typedef float f32x2 __attribute__((ext_vector_type(2))); typedef __bf16 bf16x2_t __attribute__((ext_vector_type(2)));
__device__ __forceinline__ unsigned pkbf(float lo, float hi) { f32x2 v = {lo, hi}; bf16x2_t b = __builtin_convertvector(v, bf16x2_t); return __builtin_bit_cast(unsigned, b); }
__device__ __forceinline__ float bflo(unsigned w) { return __uint_as_float(w << 16); }
__device__ __forceinline__ float bfhi(unsigned w) { return __uint_as_float(w & 0xffff0000u); }
__device__ __forceinline__ float sigm(float v) { return 1.0f / (1.0f + __expf(-v)); }
constexpr int ZP = 5632;
constexpr float ATT_C2 = 0.125f * 1.4426950408889634f;
constexpr float RMS_EPS = 1e-6f;
struct EpiInProj {
    static constexpr bool PERM = true, AFTER_DRAIN = false;
    bf16_t* Z; const float* rstd; const float* bias;
    __device__ __forceinline__ void operator()(const f32x4 (&acc)[2][2][4][2], const Unit& u, int wr, int wc, int fr, int fq) const {
        const int colt = u.pn * BM;
        const int srcoff = (colt >= 2048 ? 8 : 0) + (colt >= 3584 ? 8 : 0);
        const float sc = (colt >= 2048 && colt < 2560) ? ATT_C2 : 1.f;
        const int col0 = colt + wc * 32 + 8 * fq;
        f32x4 bv[2][2];
#pragma unroll
        for (int bj = 0; bj < 2; ++bj)
#pragma unroll
            for (int n = 0; n < 2; ++n) bv[bj][n] = *(const f32x4*)(bias + srcoff + col0 + bj * HALF + 4 * n);
#pragma unroll
        for (int ai = 0; ai < 2; ++ai)
#pragma unroll
            for (int m = 0; m < 4; ++m) { const int row = u.pm * BM + ai * HALF + wr * 64 + m * 16 + fr; const float rs = rstd[row]; bf16_t* rowp = Z + (size_t)row * ZP + col0;
#pragma unroll
                for (int bj = 0; bj < 2; ++bj) { const f32x4 v0 = (acc[ai][bj][m][0] * rs + bv[bj][0]) * sc, v1 = (acc[ai][bj][m][1] * rs + bv[bj][1]) * sc;
                    u32x4 w; w.x = pkbf(v0[0], v0[1]); w.y = pkbf(v0[2], v0[3]); w.z = pkbf(v1[0], v1[1]); w.w = pkbf(v1[2], v1[3]);
                    *(u32x4*)(rowp + bj * HALF) = w; } }
    }
};
template <int PASS> struct EpiBranch {
    static constexpr bool PERM = true, AFTER_DRAIN = false;
    bf16_t* mix; const bf16_t* Z;
    __device__ __forceinline__ void operator()(const f32x4 (&acc)[2][2][4][2], const Unit& u, int wr, int wc, int fr, int fq) const {
        const int col0 = u.pn * BM + wc * 32 + 8 * fq;
#pragma unroll
        for (int ai = 0; ai < 2; ++ai)
#pragma unroll
            for (int m = 0; m < 4; ++m) { const int row = u.pm * BM + ai * HALF + wr * 64 + m * 16 + fr;
                const bf16_t* gp = Z + (size_t)row * ZP + (PASS == 0 ? 3584 : 4608) + col0; bf16_t* mp = mix + (size_t)row * 1024 + col0;
#pragma unroll
                for (int bj = 0; bj < 2; ++bj) { const u32x4 g = *(const u32x4*)(gp + bj * HALF); const f32x4 a0 = acc[ai][bj][m][0], a1 = acc[ai][bj][m][1];
                    float v[8];
                    v[0] = sigm(bflo(g.x)) * a0[0]; v[1] = sigm(bfhi(g.x)) * a0[1]; v[2] = sigm(bflo(g.y)) * a0[2]; v[3] = sigm(bfhi(g.y)) * a0[3];
                    v[4] = sigm(bflo(g.z)) * a1[0]; v[5] = sigm(bfhi(g.z)) * a1[1]; v[6] = sigm(bflo(g.w)) * a1[2]; v[7] = sigm(bfhi(g.w)) * a1[3];
                    if (PASS == 1) { const u32x4 p = *(const u32x4*)(mp + bj * HALF);
                        v[0] += bflo(p.x); v[1] += bfhi(p.x); v[2] += bflo(p.y); v[3] += bfhi(p.y); v[4] += bflo(p.z); v[5] += bfhi(p.z); v[6] += bflo(p.w); v[7] += bfhi(p.w); }
                    u32x4 w; w.x = pkbf(v[0], v[1]); w.y = pkbf(v[2], v[3]); w.z = pkbf(v[4], v[5]); w.w = pkbf(v[6], v[7]);
                    *(u32x4*)(mp + bj * HALF) = w; } }
    }
};
struct EpiResid {
    static constexpr bool PERM = false, AFTER_DRAIN = false;
    const float* base; float* out; bf16_t* xb; float* rowss;
    __device__ __forceinline__ void operator()(const f32x4 (&acc)[2][2][4][2], const Unit& u, int wr, int wc, int fr, int fq) const {
        typedef unsigned u32x2v __attribute__((ext_vector_type(2)));
        const int col0 = u.pn * BM + wc * 32 + 4 * fq;
#pragma unroll
        for (int ai = 0; ai < 2; ++ai)
#pragma unroll
            for (int m = 0; m < 4; ++m) { const int row = u.pm * BM + ai * HALF + wr * 64 + m * 16 + fr; const size_t off = (size_t)row * 1024 + col0; float ss = 0.f;
#pragma unroll
                for (int bj = 0; bj < 2; ++bj)
#pragma unroll
                    for (int n = 0; n < 2; ++n) { const f32x4 o = *(const f32x4*)(base + off + bj * HALF + n * 16) + acc[ai][bj][m][n];
                        *(f32x4*)(out + off + bj * HALF + n * 16) = o; ss += (o[0] * o[0] + o[1] * o[1]) + (o[2] * o[2] + o[3] * o[3]);
                        if (xb) { u32x2v w; w.x = pkbf(o[0], o[1]); w.y = pkbf(o[2], o[3]); *(u32x2v*)(xb + off + bj * HALF + n * 16) = w; } }
                ss += __shfl_xor(ss, 16); ss += __shfl_xor(ss, 32);
                if (fq == 0) unsafeAtomicAdd(rowss + row, ss); }
    }
};
struct EpiSwiglu {
    static constexpr bool PERM = true, AFTER_DRAIN = false;
    bf16_t* H; const float* rowss;
    __device__ __forceinline__ void operator()(const f32x4 (&acc)[2][2][4][2], const Unit& u, int wr, int wc, int fr, int fq) const {
        const int col0 = u.pn * HALF + wc * 32 + 8 * fq;
#pragma unroll
        for (int ai = 0; ai < 2; ++ai)
#pragma unroll
            for (int m = 0; m < 4; ++m) { const int row = u.pm * BM + ai * HALF + wr * 64 + m * 16 + fr; const float rs = rsqrtf(rowss[row] * (1.0f / 1024.0f) + RMS_EPS);
                float v[8];
#pragma unroll
                for (int n = 0; n < 2; ++n)
#pragma unroll
                    for (int j = 0; j < 4; ++j) { const float g = acc[ai][0][m][n][j] * rs, up = acc[ai][1][m][n][j] * rs; v[4 * n + j] = g * sigm(g) * up; }
                u32x4 w; w.x = pkbf(v[0], v[1]); w.y = pkbf(v[2], v[3]); w.z = pkbf(v[4], v[5]); w.w = pkbf(v[6], v[7]);
                *(u32x4*)(H + (size_t)row * 2816 + col0) = w; }
    }
};
template <class Epi, class Sched, bool ALIGN_EPI = false, bool SP2 = false>
__device__ __forceinline__ void gemm_phase(PG8_LAS unsigned char* lds, const Gemm g, const Sched& S, const Epi& E) {
    const int tid = threadIdx.x, wid = __builtin_amdgcn_readfirstlane(tid >> 6), lane = tid & 63, wr = wid >> 2, wc = wid & 3, fr = lane & 15, fq = lane >> 4;
    const int K = g.K, nt = K / BK;
    unsigned voffA[2], voffB[2];
#pragma unroll
    for (int i = 0; i < 2; ++i) { int R, C; stage_rc(tid * 16 + i * 8192, R, C); const int Rb = Epi::PERM ? ((R & ~31) + perm32(R & 31)) : R;
        voffA[i] = (unsigned)(R * K + C) * 2u; voffB[i] = (unsigned)(Rb * K + C) * 2u; }
    const size_t kstep = (size_t)(BK * 2);
    const size_t hstep = (size_t)HALF * K * 2;
    const size_t tstep = 2 * hstep;
    const unsigned ldsw = (unsigned)wid * 1024u;
    const int aoff = lds_byte(wr * 64 + fr, fq * 8), boff = lds_byte(wc * 32 + fr, fq * 8);
#define PG8_SA(b, h) (((b) * 2 + (h)) * HTB)
#define PG8_SB(b, h) ((4 + (b) * 2 + (h)) * HTB)
#define PG8_STAGE(bufoff, gbase, voff) do { _Pragma("unroll") for (int _i = 0; _i < 2; ++_i) \
        __builtin_amdgcn_global_load_lds((const unsigned*)((const char*)(gbase) + (voff)[_i]), (PG8_LAS unsigned*)(lds + (bufoff) + ldsw + _i * 8192), 16, 0, 0); } while (0)
#define PG8_LDA(dst, b, h) do { _Pragma("unroll") for (int m = 0; m < 4; ++m) _Pragma("unroll") for (int k = 0; k < 2; ++k) dst[m][k] = *(const PG8_LAS bf16x8*)(lds + PG8_SA(b, h) + aoff + m * 2048 + k * 1024); } while (0)
#define PG8_LDB(dst, b, h) do { _Pragma("unroll") for (int n = 0; n < 2; ++n) _Pragma("unroll") for (int k = 0; k < 2; ++k) dst[n][k] = *(const PG8_LAS bf16x8*)(lds + PG8_SB(b, h) + boff + n * 2048 + k * 1024); } while (0)
#define PG8_MMA(ai, bj, At, Bt) do { __builtin_amdgcn_s_setprio(1); _Pragma("unroll") for (int m = 0; m < 4; ++m) _Pragma("unroll") for (int n = 0; n < 2; ++n) _Pragma("unroll") for (int k = 0; k < 2; ++k) \
        acc[ai][bj][m][n] = __builtin_amdgcn_mfma_f32_16x16x32_bf16(Bt[n][k], At[m][k], acc[ai][bj][m][n], 0, 0, 0); __builtin_amdgcn_s_setprio(0); } while (0)
#define PG8_WAIT_V(n) asm volatile("s_waitcnt vmcnt(" #n ")" ::: "memory")
#define PG8_WAIT_L(n) asm volatile("s_waitcnt lgkmcnt(" #n ")" ::: "memory")
#define PG8_BAR __builtin_amdgcn_s_barrier()
#define PG8_SCHED __builtin_amdgcn_sched_barrier(0)
    Unit cur, nxt; int ui = 0;
    if (!S.next(0, cur)) return;
    f32x4 acc[2][2][4][2];
#pragma unroll
    for (int a = 0; a < 2; ++a)
#pragma unroll
        for (int b = 0; b < 2; ++b)
#pragma unroll
            for (int m = 0; m < 4; ++m)
#pragma unroll
                for (int n = 0; n < 2; ++n) acc[a][b][m][n] = (f32x4){0.f, 0.f, 0.f, 0.f};
    bf16x8 At[4][2], B0[2][2], B1[2][2];
    const char* cA = (const char*)g.A + (size_t)cur.pm * tstep; const char* cB = (const char*)g.Bt + (size_t)cur.pn * tstep;
    S.a_ready(cur);
    if constexpr (SP2) {
        PG8_STAGE(PG8_SB(0, 0), cB, voffB); PG8_STAGE(PG8_SB(0, 1), cB + hstep, voffB); PG8_STAGE(PG8_SA(0, 0), cA, voffA); PG8_STAGE(PG8_SA(0, 1), cA + hstep, voffA);
        if (wr == 1) PG8_BAR;
        PG8_WAIT_V(2); PG8_BAR;
        PG8_STAGE(PG8_SB(1, 0), cB + kstep, voffB); PG8_STAGE(PG8_SA(1, 0), cA + kstep, voffA); PG8_STAGE(PG8_SB(1, 1), cB + hstep + kstep, voffB);
        PG8_WAIT_V(6); PG8_BAR;
    } else {
        PG8_STAGE(PG8_SB(0, 0), cB, voffB); PG8_STAGE(PG8_SA(0, 0), cA, voffA); PG8_STAGE(PG8_SB(0, 1), cB + hstep, voffB); PG8_STAGE(PG8_SA(0, 1), cA + hstep, voffA);
        if (wr == 1) PG8_BAR;
        PG8_WAIT_V(4); PG8_BAR;
        PG8_STAGE(PG8_SB(1, 0), cB + kstep, voffB); PG8_STAGE(PG8_SA(1, 0), cA + kstep, voffA); PG8_STAGE(PG8_SB(1, 1), cB + hstep + kstep, voffB);
        PG8_WAIT_V(6); PG8_BAR;
    }
    for (;;) {
        const bool has_next = S.next(ui + 1, nxt);
        const char* nA = has_next ? (const char*)g.A + (size_t)nxt.pm * tstep : cA; const char* nB = has_next ? (const char*)g.Bt + (size_t)nxt.pn * tstep : cB;
        for (int t = 0; t < nt; t += 2) {
            const bool last = (t == nt - 2);
            const char* a1 = cA + (size_t)(t + 1) * kstep;
            const char* a2 = last ? nA : cA + (size_t)(t + 2) * kstep; const char* b2 = last ? nB : cB + (size_t)(t + 2) * kstep;
            const char* a3 = a2 + kstep; const char* b3 = b2 + kstep;
            if (last && has_next) S.a_ready(nxt);
            if constexpr (SP2) {
            PG8_LDB(B0, 0, 0); PG8_LDB(B1, 0, 1); PG8_SCHED; PG8_LDA(At, 0, 0); PG8_STAGE(PG8_SA(1, 1), a1 + hstep, voffA);
            PG8_WAIT_V(8); PG8_WAIT_L(0); PG8_BAR; PG8_MMA(0, 0, At, B0); PG8_MMA(0, 1, At, B1); PG8_BAR; PG8_SCHED;
            PG8_LDA(At, 0, 1); PG8_STAGE(PG8_SB(0, 0), b2, voffB); PG8_STAGE(PG8_SB(0, 1), b2 + hstep, voffB); PG8_STAGE(PG8_SA(0, 0), a2, voffA);
            PG8_WAIT_V(8); PG8_WAIT_L(0); PG8_BAR; PG8_MMA(1, 0, At, B0); PG8_MMA(1, 1, At, B1); PG8_BAR; PG8_SCHED;
            PG8_LDB(B0, 1, 0); PG8_LDB(B1, 1, 1); PG8_SCHED; PG8_LDA(At, 1, 0); PG8_STAGE(PG8_SA(0, 1), a2 + hstep, voffA);
            PG8_WAIT_V(8); PG8_WAIT_L(0); PG8_BAR; PG8_MMA(0, 0, At, B0); PG8_MMA(0, 1, At, B1); PG8_BAR; PG8_SCHED;
            PG8_LDA(At, 1, 1); PG8_STAGE(PG8_SB(1, 0), b3, voffB); PG8_STAGE(PG8_SB(1, 1), b3 + hstep, voffB); PG8_STAGE(PG8_SA(1, 0), a3, voffA);
            PG8_WAIT_V(8); PG8_WAIT_L(0); PG8_BAR; PG8_MMA(1, 0, At, B0); PG8_MMA(1, 1, At, B1); PG8_BAR; PG8_SCHED;
            } else {
            PG8_LDB(B0, 0, 0); PG8_SCHED; PG8_LDA(At, 0, 0); PG8_STAGE(PG8_SA(1, 1), a1 + hstep, voffA);
            PG8_WAIT_L(8); PG8_BAR; PG8_WAIT_L(0); PG8_MMA(0, 0, At, B0); PG8_BAR; PG8_SCHED;
            PG8_LDB(B1, 0, 1); PG8_STAGE(PG8_SB(0, 0), b2, voffB);
            PG8_BAR; PG8_WAIT_L(0); PG8_MMA(0, 1, At, B1); PG8_BAR;
            PG8_LDA(At, 0, 1); PG8_STAGE(PG8_SA(0, 0), a2, voffA);
            PG8_BAR; PG8_WAIT_L(0); PG8_MMA(1, 0, At, B0); PG8_BAR; PG8_SCHED;
            PG8_STAGE(PG8_SB(0, 1), b2 + hstep, voffB);
            PG8_WAIT_V(6); PG8_BAR; PG8_MMA(1, 1, At, B1); PG8_BAR;
            PG8_LDB(B0, 1, 0); PG8_SCHED; PG8_LDA(At, 1, 0); PG8_STAGE(PG8_SA(0, 1), a2 + hstep, voffA);
            PG8_WAIT_L(8); PG8_BAR; PG8_WAIT_L(0); PG8_MMA(0, 0, At, B0); PG8_BAR; PG8_SCHED;
            PG8_LDB(B1, 1, 1); PG8_STAGE(PG8_SB(1, 0), b3, voffB);
            PG8_BAR; PG8_WAIT_L(0); PG8_MMA(0, 1, At, B1); PG8_BAR;
            PG8_LDA(At, 1, 1); PG8_STAGE(PG8_SA(1, 0), a3, voffA);
            PG8_BAR; PG8_WAIT_L(0); PG8_MMA(1, 0, At, B0); PG8_BAR; PG8_SCHED;
            PG8_STAGE(PG8_SB(1, 1), b3 + hstep, voffB);
            PG8_WAIT_V(6); PG8_BAR; PG8_MMA(1, 1, At, B1); PG8_BAR;
            }
        }
        if constexpr (ALIGN_EPI) { if (wr == 0) PG8_BAR; }
        if constexpr (!Epi::AFTER_DRAIN) { E(acc, cur, wr, wc, fr, fq); S.done(cur); }
        if (!has_next) break;
#pragma unroll
        for (int a = 0; a < 2; ++a)
#pragma unroll
            for (int b = 0; b < 2; ++b)
#pragma unroll
                for (int m = 0; m < 4; ++m)
#pragma unroll
                    for (int n = 0; n < 2; ++n) acc[a][b][m][n] = (f32x4){0.f, 0.f, 0.f, 0.f};
        cur = nxt; cA = nA; cB = nB; ++ui;
        if constexpr (ALIGN_EPI) { if (wr == 1) PG8_BAR; }
    }
    PG8_WAIT_V(0);
    if constexpr (!ALIGN_EPI) { if (wr == 0) PG8_BAR; }
    PG8_BAR;
    if constexpr (Epi::AFTER_DRAIN) { E.fused(acc, cur, wr, wc, fr, fq, lds, wid, lane); S.done(cur); }
#undef PG8_SA
#undef PG8_SB
#undef PG8_STAGE
#undef PG8_LDA
#undef PG8_LDB
#undef PG8_MMA
#undef PG8_WAIT_V
#undef PG8_WAIT_L
#undef PG8_BAR
#undef PG8_SCHED
}
}
namespace attn_body {
using bf16=__hip_bfloat16;
using bf16x8=__attribute__((ext_vector_type(8)))short;
using s16x4=__attribute__((ext_vector_type(4)))short;
using f32x16=__attribute__((ext_vector_type(16)))float;
using u32x4=__attribute__((ext_vector_type(4)))unsigned;
constexpr int BATCH=8,NHEAD=8,SEQ=2048,D=64,QP=5632,OP=512;
constexpr int NW=8,QBLK=32,QB=QBLK*NW,KVBLK=64,NQB=SEQ/QB;
constexpr int ATTN_UNIT_ROWS=QB;
__device__ __forceinline__ int crow(int r,int hi){return (r&3)+8*(r>>2)+4*hi;}
#define SBAR() __builtin_amdgcn_sched_barrier(0)
__device__ __forceinline__ void cmask(f32x16&p0,f32x16&p1,int jb,int qrel,int hi){
  const float NEG=-INFINITY; int kb=64*jb+4*hi;
  #pragma unroll
  for(int r=0;r<16;++r){int kv=kb+(r&3)+8*(r>>2); if(kv>qrel)p0[r]=NEG; if(kv+32>qrel)p1[r]=NEG;}
}

constexpr int NSLOT=3, SLOTB=8192;
constexpr int LDS_K=0, LDS_V=NSLOT*SLOTB, LDS_WS=2*NSLOT*SLOTB, LDS_OST=LDS_WS+NW*64*4, LDS_KB=LDS_OST+NW*4096, LDS_BYTES=LDS_KB+SEQ*4;
constexpr float C2=0.125f*1.4426950408889634f;
__device__ __forceinline__ void glds16(const void*gsrc,unsigned lds_dst){unsigned keep;
  asm volatile("s_mov_b32 %0, m0\n\ts_mov_b32 m0, %2\n\ts_nop 0\n\tglobal_load_lds_dwordx4 %1, off\n\ts_mov_b32 m0, %0":"=&s"(keep):"v"(gsrc),"s"(lds_dst):"memory");}
__device__ __forceinline__ float max3f(float a,float b,float c){float r;asm("v_max3_f32 %0, %1, %2, %3":"=v"(r):"v"(a),"v"(b),"v"(c));return r;}
__device__ __forceinline__ float max2f(float a,float b){float r;asm("v_max_f32_e32 %0, %1, %2":"=v"(r):"v"(a),"v"(b));return r;}
__device__ __forceinline__ float fadd_s(float a,float b){float r;asm("v_add_f32_e32 %0, %1, %2":"=v"(r):"v"(a),"v"(b));return r;}
__device__ __forceinline__ float fsub_s(float a,float b){float r;asm("v_sub_f32_e32 %0, %1, %2":"=v"(r):"v"(a),"v"(b));return r;}
typedef float f32x2_t __attribute__((ext_vector_type(2))); typedef __bf16 bf16x2_t __attribute__((ext_vector_type(2)));
__device__ __forceinline__ unsigned cvtpk_s(float lo,float hi){f32x2_t v={lo,hi};bf16x2_t b=__builtin_convertvector(v,bf16x2_t);return __builtin_bit_cast(unsigned,b);}
#define WAIT_BAR(N) asm volatile("s_waitcnt vmcnt(" #N ") lgkmcnt(0)\n\ts_barrier":::"memory")

__device__ __forceinline__ void qkt(f32x16&p0,f32x16&p1,const char*Kslot,const bf16x8*qr,const f32x16&i0,const f32x16&i1,int r32,int hi){
  const char*kb=Kslot+hi*1024+r32*16;
  #pragma unroll
  for(int d0=0;d0<4;++d0){
    const bf16x8 b0=*reinterpret_cast<const bf16x8*>(kb+d0*2048);
    const bf16x8 b1=*reinterpret_cast<const bf16x8*>(kb+d0*2048+512);
    if(d0==0){p0=__builtin_amdgcn_mfma_f32_32x32x16_bf16(b0,qr[0],i0,0,0,0);p1=__builtin_amdgcn_mfma_f32_32x32x16_bf16(b1,qr[0],i1,0,0,0);}
    else{p0=__builtin_amdgcn_mfma_f32_32x32x16_bf16(b0,qr[d0],p0,0,0,0);p1=__builtin_amdgcn_mfma_f32_32x32x16_bf16(b1,qr[d0],p1,0,0,0);}}
}
typedef __attribute__((address_space(3))) const char* lds_cptr;
typedef short v4i16_t __attribute__((ext_vector_type(4)));
__device__ __forceinline__ void kload8(bf16x8*kf,lds_cptr kp){
  kf[0]=*(const __attribute__((address_space(3))) bf16x8*)(kp);      kf[1]=*(const __attribute__((address_space(3))) bf16x8*)(kp+512);
  kf[2]=*(const __attribute__((address_space(3))) bf16x8*)(kp+2048); kf[3]=*(const __attribute__((address_space(3))) bf16x8*)(kp+2560);
  kf[4]=*(const __attribute__((address_space(3))) bf16x8*)(kp+4096); kf[5]=*(const __attribute__((address_space(3))) bf16x8*)(kp+4608);
  kf[6]=*(const __attribute__((address_space(3))) bf16x8*)(kp+6144); kf[7]=*(const __attribute__((address_space(3))) bf16x8*)(kp+6656);
}
__device__ __forceinline__ void kload2(bf16x8*kf,lds_cptr kp,int j){ kf[2*j]=*(const __attribute__((address_space(3))) bf16x8*)(kp+j*2048); kf[2*j+1]=*(const __attribute__((address_space(3))) bf16x8*)(kp+j*2048+512); }
__device__ __forceinline__ s16x4 vtr(lds_cptr p){ return __builtin_bit_cast(s16x4,__builtin_amdgcn_ds_read_tr16_b64_v4i16((__attribute__((address_space(3))) v4i16_t*)p)); }
__device__ __forceinline__ float rowmax(const f32x16&p0,const f32x16&p1){
  float a=max3f(p0[0],p0[1],p1[0]),b=max3f(p0[2],p0[3],p1[1]);a=max3f(a,p1[2],p1[3]);
  #pragma unroll
  for(int r=4;r<16;r+=4){a=max3f(a,p0[r],p0[r+1]);b=max3f(b,p0[r+2],p0[r+3]);a=max3f(a,p1[r],p1[r+1]);b=max3f(b,p1[r+2],p1[r+3]);}
  const float m=max2f(a,b);
  auto rr=__builtin_amdgcn_permlane32_swap(__float_as_uint(m),__float_as_uint(m),false,false);
  return max2f(__uint_as_float(rr[0]),__uint_as_float(rr[1]));
}
__device__ __forceinline__ void pv(f32x16*o,int vb,bf16x8 pa0,bf16x8 pa1,bf16x8 pa2,bf16x8 pa3){
  #pragma unroll
  for(int d0=0;d0<2;++d0){s16x4 lo[4],hi[4];
    #pragma unroll
    for(int ks=0;ks<4;++ks){
      asm volatile("ds_read_b64_tr_b16 %0,%1 offset:%c2":"=&v"(lo[ks]):"v"(vb),"i"(d0*4096+ks*1024):"memory");
      asm volatile("ds_read_b64_tr_b16 %0,%1 offset:%c2":"=&v"(hi[ks]):"v"(vb),"i"(d0*4096+ks*1024+512):"memory");}
    asm volatile("s_waitcnt lgkmcnt(0)":::"memory");SBAR();
    #define PK(k) (bf16x8){lo[k][0],lo[k][1],lo[k][2],lo[k][3],hi[k][0],hi[k][1],hi[k][2],hi[k][3]}
    o[d0]=__builtin_amdgcn_mfma_f32_32x32x16_bf16(pa0,PK(0),o[d0],0,0,0);
    o[d0]=__builtin_amdgcn_mfma_f32_32x32x16_bf16(pa1,PK(1),o[d0],0,0,0);
    o[d0]=__builtin_amdgcn_mfma_f32_32x32x16_bf16(pa2,PK(2),o[d0],0,0,0);
    o[d0]=__builtin_amdgcn_mfma_f32_32x32x16_bf16(pa3,PK(3),o[d0],0,0,0);
    #undef PK
  }
}

#ifndef ATTN_STORE16
#define ATTN_STORE16(p,v) (*(u32x4*)(p)=(v))
#endif
template<int THRL> __device__ __forceinline__ void attn_unit(int b,int h,int qb,const bf16*Q,const bf16*__restrict__ K,const bf16*__restrict__ V,bf16*O,const float*__restrict__ cum,char*shm){
  const int tid=threadIdx.x,lane=tid&63,r32=lane&31,hi=lane>>5; const int wid=__builtin_amdgcn_readfirstlane(tid>>6);
  const long rowbase=(long)b*SEQ; const int q0=qb*QB;
  {
    __attribute__((address_space(3))) float* kbw=(__attribute__((address_space(3))) float*)((__attribute__((address_space(3))) char*)shm+LDS_KB);
    const float cref=cum[q0];
    for(int i=tid;i<q0+QB;i+=NW*64) kbw[i]=(cref-cum[i])*1.4426950408889634f; }
  const bf16*Qw=Q+(rowbase+q0+wid*QBLK)*QP+h*D;
  const bf16*Kh=K+rowbase*QP+h*D,*Vh=V+rowbase*QP+h*D;
  const unsigned lds0=(unsigned)(uintptr_t)shm;
  float*wsf=(float*)(shm+LDS_WS)+wid*64;
  const bf16*ksrc=Kh+(long)lane*QP+wid*8;
  const bf16*vsrc=Vh+(long)(16*(wid&3)+(lane>>2))*QP+(wid>>2)*32+(lane&3)*8;
  const unsigned kdst=lds0+LDS_K+wid*1024, vdst=lds0+LDS_V+wid*1024;
  #define DMA_K(t,slot) glds16(ksrc+(long)(t)*KVBLK*QP,(unsigned)__builtin_amdgcn_readfirstlane(kdst+(slot)))
  #define DMA_V(t,slot) glds16(vsrc+(long)(t)*KVBLK*QP,(unsigned)__builtin_amdgcn_readfirstlane(vdst+(slot)))
  const int vb0=(int)(lds0+LDS_V)+((lane>>4)&1)*32+(lane&3)*8+(4*hi+((lane&15)>>2))*64;
  const char*Kbase=shm+LDS_K; bf16x8 kf[8];
  const lds_cptr shm3=(lds_cptr)shm; const lds_cptr kp0=shm3+LDS_K+hi*1024+r32*16; const lds_cptr vp0=shm3+LDS_V+((lane>>4)&1)*32+(lane&3)*8+(4*hi+((lane&15)>>2))*64;
  const int NT=(q0+QB)/KVBLK;
  DMA_K(0,0);DMA_V(0,0);DMA_K(1,SLOTB);
  bf16x8 qr[4];
  #pragma unroll
  for(int d0=0;d0<4;++d0)qr[d0]=*reinterpret_cast<const bf16x8*>(&Qw[(long)r32*QP+d0*16+hi*8]);
  float mhat=0.f,l_reg=0.f;f32x16 o[2];o[0]=f32x16{};o[1]=f32x16{};
  const int qrel=wid*QBLK+r32;
  #define CMASK(P0,P1,t) do{int jb_=(t)-(NT-4); if(jb_>=0)cmask(P0,P1,jb_,qrel,hi);}while(0)
  typedef float kbf4 __attribute__((ext_vector_type(4)));
  const __attribute__((address_space(3))) float* kbr=(const __attribute__((address_space(3))) float*)(shm3+LDS_KB)+4*hi;
  #define INITB1(P0,t,OFF) do{ const __attribute__((address_space(3))) float* kb_=kbr+64*(t)+(OFF); \
    _Pragma("unroll") for(int g_=0;g_<4;++g_){ const kbf4 b0_=*(const __attribute__((address_space(3))) kbf4*)(kb_+8*g_); \
      P0[4*g_]=b0_.x-mhat; P0[4*g_+1]=b0_.y-mhat; P0[4*g_+2]=b0_.z-mhat; P0[4*g_+3]=b0_.w-mhat; } }while(0)
  #define INITB(P0,P1,t) do{ INITB1(P0,t,0); INITB1(P1,t,32); }while(0)
  bool resc=false;
  #define START(P0,P1) do{ const float rm=rowmax(P0,P1); resc=false; \
    { const float dl=rm; mhat=fadd_s(mhat,dl); \
      _Pragma("unroll") for(int r=0;r<16;++r){P0[r]=fsub_s(P0[r],dl);P1[r]=fsub_s(P1[r],dl);} \
      } \
    _Pragma("unroll") for(int r=0;r<16;++r)P0[r]=__builtin_amdgcn_exp2f(P0[r]); }while(0)
  #define RESC() do{ if(resc){ asm volatile("s_waitcnt lgkmcnt(0)":::"memory"); \
      _Pragma("unroll") for(int d_=0;d_<2;++d_) _Pragma("unroll") for(int r=0;r<16;++r)o[d_][r]*=wsf[crow(r,hi)]; } }while(0)
  f32x16 pA0,pA1,pB0,pB1;
  int sl_prev=0,sl_cur=0,sl_next=SLOTB;
  #define ROT() do{sl_prev=sl_cur;sl_cur=sl_next;sl_next=(sl_next==(NSLOT-1)*SLOTB)?0:sl_next+SLOTB;}while(0)
  DMA_K(2,2*SLOTB);
  WAIT_BAR(3);
  INITB(pA0,pA1,0); qkt(pA0,pA1,Kbase,qr,pA0,pA1,r32,hi);asm volatile("s_nop 15\n\ts_nop 7":"+v"(pA0),"+v"(pA1));CMASK(pA0,pA1,0);
  START(pA0,pA1);
  _Pragma("unroll") for(int r=0;r<16;++r)pA1[r]=__builtin_amdgcn_exp2f(pA1[r]);
  WAIT_BAR(0);
  DMA_K(3,0);DMA_V(1,SLOTB);
  ROT();
  kload8(kf,kp0+sl_cur);
  WAIT_BAR(2);
  s16x4 vlo[8],vhi[8]; u32x4 pw0,pw1,pw2,pw3;
  #define PKW(P,B) cvtpk_s(P[B],P[B+1])
  #define PAF(k) __builtin_bit_cast(bf16x8,pw##k)
  #define VFR(i) (bf16x8){vlo[i][0],vlo[i][1],vlo[i][2],vlo[i][3],vhi[i][0],vhi[i][1],vhi[i][2],vhi[i][3]}
  #define PIN(x) asm volatile("":"+v"(x))
  #define MX3(a,b,c) __builtin_fmaxf(__builtin_fmaxf((a),(b)),(c))
  #define GAPA(MF,A0,A1,A2,A3,W0,W1,PW) do{ MF; sacc+=A0; sacc+=A1; sacc+=A2; sacc+=A3; PIN(sacc); W0; W1; PIN(PW); SBAR(); }while(0)
  #define EX(v) __builtin_amdgcn_exp2f(v)
  #define GAPB(MF,X,B) do{ MF; X[B]=EX(X[B]); X[B+1]=EX(X[B+1]); X[B+2]=EX(X[B+2]); X[B+3]=EX(X[B+3]); PIN(X); SBAR(); }while(0)
  #define VRD(i) do{ vlo[i]=vtr(vp_+(((i)>>2)*4096+((i)&3)*1024)); vhi[i]=vtr(vp_+(((i)>>2)*4096+((i)&3)*1024+512)); }while(0)
  #define KRD(G,j) do{ if(G){ kload2(kf,kp0+sl_next,j); SBAR(); } }while(0)
  #define STEP(C0,C1,P0,P1,t,GK,GV,GL) do{ SBAR(); INITB1(C0,t,0); SBAR(); \
    const lds_cptr vp_=vp0+sl_prev; \
    VRD(0); SBAR(); float sacc=(P0[0]+P0[1]); \
    GAPA(C0=__builtin_amdgcn_mfma_f32_32x32x16_bf16(kf[0],qr[0],C0,0,0,0), P0[2],P0[3],P0[4],P0[5],     pw0[0]=PKW(P0,0), pw0[1]=PKW(P0,2), pw0); \
    VRD(4); INITB1(C1,t,32); SBAR(); GAPA(C1=__builtin_amdgcn_mfma_f32_32x32x16_bf16(kf[1],qr[0],C1,0,0,0), P0[6],P0[7],P0[8],P0[9],     pw0[2]=PKW(P0,4), pw0[3]=PKW(P0,6), pw0); \
    VRD(1); SBAR(); GAPA(C0=__builtin_amdgcn_mfma_f32_32x32x16_bf16(kf[2],qr[1],C0,0,0,0),   P0[10],P0[11],P0[12],P0[13], pw1[0]=PKW(P0,8), pw1[1]=PKW(P0,10), pw1); \
    VRD(5); SBAR(); GAPA(C1=__builtin_amdgcn_mfma_f32_32x32x16_bf16(kf[3],qr[1],C1,0,0,0),   P0[14],P0[15],P1[0],P1[1],   pw1[2]=PKW(P0,12),pw1[3]=PKW(P0,14), pw1); \
    VRD(2); SBAR(); GAPA(C0=__builtin_amdgcn_mfma_f32_32x32x16_bf16(kf[4],qr[2],C0,0,0,0),   P1[2],P1[3],P1[4],P1[5],     pw2[0]=PKW(P1,0), pw2[1]=PKW(P1,2), pw2); \
    VRD(6); SBAR(); GAPA(C1=__builtin_amdgcn_mfma_f32_32x32x16_bf16(kf[5],qr[2],C1,0,0,0),   P1[6],P1[7],P1[8],P1[9],     pw2[2]=PKW(P1,4), pw2[3]=PKW(P1,6), pw2); \
    VRD(3); SBAR(); GAPA(C0=__builtin_amdgcn_mfma_f32_32x32x16_bf16(kf[6],qr[3],C0,0,0,0),   P1[10],P1[11],P1[12],P1[13], pw3[0]=PKW(P1,8), pw3[1]=PKW(P1,10), pw3); \
    VRD(7); SBAR(); GAPA(C1=__builtin_amdgcn_mfma_f32_32x32x16_bf16(kf[7],qr[3],C1,0,0,0),   P1[14],P1[15],0.f,0.f,       pw3[2]=PKW(P1,12),pw3[3]=PKW(P1,14), pw3); \
    l_reg+=sacc; \
    if(GK){DMA_K((t)+3,sl_cur);} if(GV){DMA_V((t)+1,sl_next);} \
    CMASK(C0,C1,t); \
    { float a=MX3(C0[0],C0[1],C1[0]),b=MX3(C0[2],C0[3],C1[1]); a=MX3(a,C1[2],C1[3]); \
      _Pragma("unroll") for(int r=4;r<16;r+=4){a=MX3(a,C0[r],C0[r+1]);b=MX3(b,C0[r+2],C0[r+3]);a=MX3(a,C1[r],C1[r+1]);b=MX3(b,C1[r+2],C1[r+3]);} \
      float rm=__builtin_fmaxf(a,b); { auto rr=__builtin_amdgcn_permlane32_swap(__float_as_uint(rm),__float_as_uint(rm),false,false); rm=__builtin_fmaxf(__uint_as_float(rr[0]),__uint_as_float(rr[1])); } \
      resc=false; \
      if(__builtin_expect(__any(rm>(float)THRL),0)){ const float dl=__builtin_fmaxf(rm,0.f); mhat+=dl; \
        _Pragma("unroll") for(int r=0;r<16;++r){C0[r]-=dl;C1[r]-=dl;} \
        const float f=__builtin_amdgcn_exp2f(-dl); l_reg*=f; if(hi==0)wsf[r32]=f; resc=true; } } \
    SBAR(); \
    GAPB(o[0]=__builtin_amdgcn_mfma_f32_32x32x16_bf16(PAF(0),VFR(0),o[0],0,0,0), C0,0); \
    GAPB(o[1]=__builtin_amdgcn_mfma_f32_32x32x16_bf16(PAF(0),VFR(4),o[1],0,0,0), C0,4); \
    KRD(GL,0); GAPB(o[0]=__builtin_amdgcn_mfma_f32_32x32x16_bf16(PAF(1),VFR(1),o[0],0,0,0), C0,8); \
    KRD(GL,1); GAPB(o[1]=__builtin_amdgcn_mfma_f32_32x32x16_bf16(PAF(1),VFR(5),o[1],0,0,0), C0,12); \
    KRD(GL,2); GAPB(o[0]=__builtin_amdgcn_mfma_f32_32x32x16_bf16(PAF(2),VFR(2),o[0],0,0,0), C1,0); \
    KRD(GL,3); GAPB(o[1]=__builtin_amdgcn_mfma_f32_32x32x16_bf16(PAF(2),VFR(6),o[1],0,0,0), C1,4); \
    GAPB(o[0]=__builtin_amdgcn_mfma_f32_32x32x16_bf16(PAF(3),VFR(3),o[0],0,0,0), C1,8); \
    GAPB(o[1]=__builtin_amdgcn_mfma_f32_32x32x16_bf16(PAF(3),VFR(7),o[1],0,0,0), C1,12); \
    }while(0)
  int t=1;
  #undef CMASK
  #define CMASK(P0,P1,t) do{}while(0)
  for(;t+5<NT;t+=2){
    STEP(pB0,pB1,pA0,pA1,t,true,true,true);     WAIT_BAR(2); RESC(); ROT();
    STEP(pA0,pA1,pB0,pB1,t+1,true,true,true);   WAIT_BAR(2); RESC(); ROT();
  }
  #undef CMASK
  #define CMASK(P0,P1,t) do{int jb_=(t)-(NT-4); if(jb_>=0)cmask(P0,P1,jb_,qrel,hi);}while(0)
  #define ENDW(tt) do{ if((tt)+3<NT){WAIT_BAR(2);} else if((tt)+2<NT){WAIT_BAR(1);} else {WAIT_BAR(0);} }while(0)
  for(;t+1<NT;t+=2){
    STEP(pB0,pB1,pA0,pA1,t,(t+3<NT),(t+1<NT),(t+1<NT));       ENDW(t);   RESC(); ROT();
    STEP(pA0,pA1,pB0,pB1,t+1,(t+4<NT),(t+2<NT),(t+2<NT));     ENDW(t+1); RESC(); ROT();
  }
  STEP(pB0,pB1,pA0,pA1,NT-1,false,false,false); RESC();
  { float sacc=pB0[0]+pB0[1]; _Pragma("unroll") for(int r=2;r<16;++r)sacc+=pB0[r]; _Pragma("unroll") for(int r=0;r<16;++r)sacc+=pB1[r]; l_reg+=sacc;
    pw0=(u32x4){PKW(pB0,0),PKW(pB0,2),PKW(pB0,4),PKW(pB0,6)};pw1=(u32x4){PKW(pB0,8),PKW(pB0,10),PKW(pB0,12),PKW(pB0,14)};pw2=(u32x4){PKW(pB1,0),PKW(pB1,2),PKW(pB1,4),PKW(pB1,6)};pw3=(u32x4){PKW(pB1,8),PKW(pB1,10),PKW(pB1,12),PKW(pB1,14)};
    SBAR(); pv(o,vb0+sl_cur,PAF(0),PAF(1),PAF(2),PAF(3)); }
  #undef PKW
  #undef PAF
  #undef VFR
  #undef PIN
  #undef MX3
  #undef GAPA
  #undef GAPB
  #undef EX
  #undef VRD
  #undef KRD
  #undef STEP
  #undef ENDW
  {auto rr=__builtin_amdgcn_permlane32_swap(__float_as_uint(l_reg),__float_as_uint(l_reg),false,false);l_reg=__uint_as_float(rr[0])+__uint_as_float(rr[1]);}
  if(hi==0)wsf[32+r32]=l_reg;asm volatile("s_waitcnt lgkmcnt(0)":::"memory");
  float rli[16];
  #pragma unroll
  for(int r=0;r<16;++r)rli[r]=__builtin_amdgcn_rcpf(wsf[32+crow(r,hi)]);
  bf16*Ow=O+(rowbase+q0+wid*QBLK)*OP+h*D;
  { bf16*stg=(bf16*)(shm+LDS_OST)+wid*2048;
    #pragma unroll
    for(int r=0;r<16;++r){const int orow=crow(r,hi);
      #pragma unroll
      for(int d0=0;d0<2;++d0)stg[orow*64+d0*32+r32]=__float2bfloat16(o[d0][r]*rli[r]);}
    asm volatile("s_waitcnt lgkmcnt(0)":::"memory");
    #pragma unroll
    for(int i=0;i<4;++i){const int row=i*8+(lane>>3),ch=lane&7; const u32x4 v=*(const u32x4*)(stg+row*64+ch*8); ATTN_STORE16(Ow+(long)row*OP+ch*8,v);} }
  asm volatile("s_waitcnt lgkmcnt(0)\n\ts_barrier":::"memory");
  #undef DMA_K
  #undef DMA_V
  #undef CMASK
  #undef INITB
  #undef INITB1
  #undef START
  #undef RESC
  #undef ROT
}
constexpr int ATTN_LDS_BYTES=LDS_BYTES;
struct AttnTensors { const bf16* Q; const bf16* K; const bf16* V; bf16* O; const float* cum; };
struct AttnUnit { int bh; int qb; };
struct StaticOrder {
  int vcu;
  __device__ __forceinline__ explicit StaticOrder(int vcu_):vcu(vcu_){}
  __device__ __forceinline__ bool next(int i,AttnUnit&u)const{ if(i>=2||vcu>=256)return false; const int s=vcu&3; u.bh=vcu>>2; u.qb=(i==0)?7-s:s; return true; }
  __device__ __forceinline__ void a_ready(const AttnUnit&)const{}
  __device__ __forceinline__ void done(const AttnUnit&)const{}
};
template<class Sched,int THRL=8> __device__ __forceinline__ void attn_phase(char*lds,const AttnTensors&T,const Sched&S){
  AttnUnit u;
  for(int i=0;S.next(i,u);++i){ S.a_ready(u); attn_unit<THRL>(u.bh/NHEAD,u.bh%NHEAD,u.qb,T.Q,T.K,T.V,T.O,T.cum+(long)u.bh*SEQ,lds); S.done(u); }
}
#undef SBAR
#undef WAIT_BAR
}
namespace cg = cooperative_groups;
#define LAS __attribute__((address_space(3)))
typedef unsigned short bf16_t;
typedef unsigned v4u __attribute__((ext_vector_type(4)));
typedef unsigned v2u __attribute__((ext_vector_type(2)));
typedef float f32x4 __attribute__((ext_vector_type(4)));
typedef short bf16x8 __attribute__((ext_vector_type(8)));
using pg8::pkbf; using pg8::bflo; using pg8::bfhi; using pg8::sigm;
constexpr int NWAVES = 8, NTHR = 512;
constexpr int T = 16384, DMODEL = 1024, SEQ = 2048, NB = 8, ZP = 5632, NIN = 5648, DFF = 2816;
constexpr float EPS = 1e-6f;
constexpr size_t MiB = 1u << 20;
constexpr size_t WS_RSTD1 = 64 * 1024, WS_RSS2 = 128 * 1024, WS_RSS3 = 192 * 1024, WS_MPREV = 256 * 1024;
constexpr size_t WS_GATES = 1 * MiB;
constexpr size_t WS_CUMF = 2 * MiB;
constexpr size_t WS_NPREV = 2 * MiB + 512 * 1024;
constexpr size_t WS_WIN = 3 * MiB, WS_WGU = 14 * MiB, WS_WD = 25 * MiB, WS_WBM = 31 * MiB, WS_WBF = 32 * MiB, WS_WOUT = 33 * MiB;
constexpr size_t WS_XB = 35 * MiB;
constexpr size_t WS_Z = 67 * MiB;
constexpr size_t WS_H = WS_Z;
constexpr size_t WS_X1B = WS_Z + 88 * MiB;
constexpr size_t WS_END = WS_Z + 176 * MiB;
constexpr size_t OUT_YM = 0, OUT_YF = 16 * MiB, OUT_CST = 32 * MiB;

constexpr int LDS_BYTES = 147456;
constexpr int MISC_OFF = 131072 + 320;
#define GAS __attribute__((address_space(1)))

struct Args { const float* in[15]; float* out; unsigned char* ws; int ph_lo, ph_hi; };

__device__ __forceinline__ float logsig(float v) { return fminf(v, 0.f) - log1pf(expf(-fabsf(v))); }
__device__ __forceinline__ float silu(float v) { return v / (1.0f + __expf(-v)); }

__device__ __forceinline__ void p0_transpose_item(const float* __restrict__ W, int ldw, int K, bf16_t* WT, int dest_row0, int src_col0, const float* __restrict__ kscale, LAS float* scr, int kb, int lane) {
    const int k0 = 64 * kb;
#pragma unroll 8
    for (int i = 0; i < 32; ++i) { const int kk = 2 * i + (lane >> 5); const float sc = kscale ? kscale[k0 + kk] : 1.f; scr[kk * 33 + (lane & 31)] = W[(size_t)(k0 + kk) * ldw + src_col0 + (lane & 31)] * sc; }
    asm volatile("s_waitcnt lgkmcnt(0)" ::: "memory");
    const int c = lane & 7;
#pragma unroll
    for (int j = 0; j < 4; ++j) { const int n = (lane >> 3) + 8 * j; const LAS float* s = scr + (8 * c) * 33 + n;
        v4u o; o.x = pkbf(s[0 * 33], s[1 * 33]); o.y = pkbf(s[2 * 33], s[3 * 33]); o.z = pkbf(s[4 * 33], s[5 * 33]); o.w = pkbf(s[6 * 33], s[7 * 33]);
        *(v4u*)(WT + (size_t)(dest_row0 + n) * K + k0 + 8 * c) = o; }
    asm volatile("s_waitcnt lgkmcnt(0)" ::: "memory");
}
__device__ __forceinline__ void p0_row_group(const float* __restrict__ x, const float* __restrict__ g1, const float* __restrict__ w_in, const float* __restrict__ b_in,
                                             bf16_t* xb, float* rstd1, float* gates, int grp, int lane) {
    const int m = lane & 15, kq = lane >> 4, row0 = 16 * grp;
    const float* xr = x + (size_t)(row0 + m) * DMODEL + 8 * kq;
    bf16_t* xo = xb + (size_t)(row0 + m) * DMODEL + 8 * kq;
    const int gsrc = (m < 8) ? 2048 + m : 3584 + m;
    const float* wp = w_in + gsrc + (size_t)(8 * kq) * NIN;
    const float* gp = g1 + 8 * kq;
    f32x4 acc = {0.f, 0.f, 0.f, 0.f}; float ss = 0.f;
#pragma unroll 2
    for (int it = 0; it < 32; ++it) {
        const f32x4 a0 = *(const f32x4*)(xr + 32 * it), a1 = *(const f32x4*)(xr + 32 * it + 4);
        const f32x4 s0 = *(const f32x4*)(gp + 32 * it), s1 = *(const f32x4*)(gp + 32 * it + 4);
        float bw[8];
#pragma unroll
        for (int i = 0; i < 8; ++i) bw[i] = wp[(size_t)(32 * it + i) * NIN];
        ss += (a0[0] * a0[0] + a0[1] * a0[1]) + (a0[2] * a0[2] + a0[3] * a0[3]) + (a1[0] * a1[0] + a1[1] * a1[1]) + (a1[2] * a1[2] + a1[3] * a1[3]);
        v4u o; o.x = pkbf(a0[0], a0[1]); o.y = pkbf(a0[2], a0[3]); o.z = pkbf(a1[0], a1[1]); o.w = pkbf(a1[2], a1[3]);
        *(v4u*)(xo + 32 * it) = o;
#pragma unroll
        for (int i = 0; i < 4; ++i) acc = __builtin_amdgcn_mfma_f32_16x16x4f32(a0[i], bw[i] * s0[i], acc, 0, 0, 0);
#pragma unroll
        for (int i = 0; i < 4; ++i) acc = __builtin_amdgcn_mfma_f32_16x16x4f32(a1[i], bw[4 + i] * s1[i], acc, 0, 0, 0);
    }
    ss += __shfl_xor(ss, 16); ss += __shfl_xor(ss, 32);
    const float rstd = rsqrtf(ss * (1.0f / DMODEL) + EPS);
    if (kq == 0) rstd1[row0 + m] = rstd;
    const float bias = b_in[(m < 8) ? 2048 + m : 3584 + m];
#pragma unroll
    for (int r = 0; r < 4; ++r) { const int rr = 4 * kq + r; const float rs = __shfl(rstd, rr); float v = acc[r] * rs + bias; if (m >= 4) v = logsig(v); gates[(size_t)(row0 + rr) * 16 + m] = v; }
}
__device__ __forceinline__ void fox_cumsum(const float* __restrict__ gates, float* cumf, int bh, int lane) {
    const int b = bh >> 3, h = bh & 7; const float* gp = gates + ((size_t)b * SEQ + 32 * lane) * 16 + 8 + h;
    float tot = 0.f;
#pragma unroll 8
    for (int j = 0; j < 32; ++j) tot += gp[j * 16];
    float incl = tot;
#pragma unroll
    for (int o = 1; o < 64; o <<= 1) { const float t = __shfl_up(incl, o); if (lane >= o) incl += t; }
    float run = incl - tot; float* cp = cumf + (size_t)bh * SEQ + 32 * lane;
#pragma unroll 8
    for (int j = 0; j < 32; ++j) { run += gp[j * 16]; cp[j] = run; }
}
__device__ __forceinline__ void conv8(const bf16_t* zrow, int tpos, const float* __restrict__ cw, const float* __restrict__ cb, int ch0, float (&o)[8]) {
    const f32x4 b0 = *(const f32x4*)(cb + ch0), b1 = *(const f32x4*)(cb + ch0 + 4);
    o[0] = b0[0]; o[1] = b0[1]; o[2] = b0[2]; o[3] = b0[3]; o[4] = b1[0]; o[5] = b1[1]; o[6] = b1[2]; o[7] = b1[3];
#pragma unroll
    for (int j = 0; j < 4; ++j) { const int tt = tpos - 3 + j;
        if (tt >= 0) { const v4u r = *(const v4u*)(zrow + (long)(j - 3) * ZP); const f32x4 w0 = *(const f32x4*)(cw + j * 1024 + ch0), w1 = *(const f32x4*)(cw + j * 1024 + ch0 + 4);
            o[0] += w0[0] * bflo(r.x); o[1] += w0[1] * bfhi(r.x); o[2] += w0[2] * bflo(r.y); o[3] += w0[3] * bfhi(r.y);
            o[4] += w1[0] * bflo(r.z); o[5] += w1[1] * bfhi(r.z); o[6] += w1[2] * bflo(r.w); o[7] += w1[3] * bfhi(r.w); } }
#pragma unroll
    for (int i = 0; i < 8; ++i) o[i] = silu(o[i]);
}
__device__ __forceinline__ void chunk_gates(const float* __restrict__ gates, int b, int h, int c, int lane, float& bcum, float& g) {
    const float* gp = gates + ((size_t)b * SEQ + c * 64 + lane) * 16;
    const float ic = gp[h], fc = gp[4 + h];
    float incl = fc;
#pragma unroll
    for (int o = 1; o < 64; o <<= 1) { const float t = __shfl_up(incl, o); if (lane >= o) incl += t; }
    bcum = incl; g = ic - incl;
}
__device__ __forceinline__ float wave_max(float v) {
#pragma unroll
    for (int o = 1; o < 64; o <<= 1) v = fmaxf(v, __shfl_xor(v, o));
    return v;
}
constexpr int MS_KT = 0, MS_KT_BYTES = 16 * 72 * 2, MS_VT = 2 * MS_KT_BYTES, MS_VT_BYTES = 128 * 72 * 2;
__device__ __forceinline__ void mlstm_state_item(LAS unsigned char* lds, const bf16_t* __restrict__ Z, const float* __restrict__ gates, const float* __restrict__ conv_w, const float* __restrict__ conv_b,
                                                 bf16_t* CstT, float* nprev, float* mprev, int bh, int slice) {
    const int tid = threadIdx.x, lane = tid & 63, wave = __builtin_amdgcn_readfirstlane(tid >> 6);
    const int b = bh >> 2, h = bh & 3;
    const int vs = tid >> 3, vpart = tid & 7;
    const int ks = tid >> 1, kdp = tid & 1;
    const int kch = 512 + h * 128 + slice * 16 + 8 * kdp;
    const bf16_t* vsrc = Z + ((size_t)b * SEQ + vs) * ZP + 1024 + h * 128 + 16 * vpart;
    const bf16_t* ksrc = Z + ((size_t)b * SEQ + ks) * ZP + kch;
    f32x4 acc = {0.f, 0.f, 0.f, 0.f}; float nst = 0.f, m_prev = 0.f;
    for (int c = 0; c < 32; ++c) {
        const int buf = c & 1;
        LAS bf16_t* kT = (LAS bf16_t*)(lds + MS_KT + buf * MS_KT_BYTES); LAS bf16_t* vT = (LAS bf16_t*)(lds + MS_VT + buf * MS_VT_BYTES);
        float bcum, g; chunk_gates(gates, b, h, c, lane, bcum, g);
        const float M63 = fmaxf(m_prev, wave_max(g)); const float w = expf(g - M63), decay = expf(m_prev - M63), blast = __shfl(bcum, 63);
        { const int dv = 16 * wave + (lane & 15), dk0 = slice * 16 + 4 * (lane >> 4);
          v2u o; o.x = pkbf(acc[0], acc[1]); o.y = pkbf(acc[2], acc[3]);
          *(v2u*)(CstT + ((size_t)(bh * 32 + c) * 128 + dv) * 128 + dk0) = o;
          if (wave == 0 && lane < 16) nprev[(size_t)(bh * 32 + c) * 128 + slice * 16 + lane] = nst;
          if (slice == 0 && tid == 0) mprev[bh * 32 + c] = m_prev; }
        { const v4u r0 = *(const v4u*)(vsrc + (size_t)c * 64 * ZP), r1 = *(const v4u*)(vsrc + (size_t)c * 64 * ZP + 8);
          LAS bf16_t* d = vT + (16 * vpart) * 72 + vs;
          d[0 * 72] = (bf16_t)(r0.x & 0xffff); d[1 * 72] = (bf16_t)(r0.x >> 16); d[2 * 72] = (bf16_t)(r0.y & 0xffff); d[3 * 72] = (bf16_t)(r0.y >> 16);
          d[4 * 72] = (bf16_t)(r0.z & 0xffff); d[5 * 72] = (bf16_t)(r0.z >> 16); d[6 * 72] = (bf16_t)(r0.w & 0xffff); d[7 * 72] = (bf16_t)(r0.w >> 16);
          d[8 * 72] = (bf16_t)(r1.x & 0xffff); d[9 * 72] = (bf16_t)(r1.x >> 16); d[10 * 72] = (bf16_t)(r1.y & 0xffff); d[11 * 72] = (bf16_t)(r1.y >> 16);
          d[12 * 72] = (bf16_t)(r1.z & 0xffff); d[13 * 72] = (bf16_t)(r1.z >> 16); d[14 * 72] = (bf16_t)(r1.w & 0xffff); d[15 * 72] = (bf16_t)(r1.w >> 16); }
        { const float ws = __shfl(w, (wave & 1) * 32 + (lane >> 1)) * 0.08838834764831845f;
          if (tid < 128) { float kv[8]; conv8(ksrc + (size_t)c * 64 * ZP, c * 64 + ks, conv_w, conv_b, kch, kv);
            LAS bf16_t* d = kT + (8 * kdp) * 72 + ks;
#pragma unroll
            for (int i = 0; i < 8; i += 2) { const unsigned p = pkbf(kv[i] * ws, kv[i + 1] * ws); d[i * 72] = (bf16_t)(p & 0xffff); d[(i + 1) * 72] = (bf16_t)(p >> 16); } } }
        __syncthreads();
        { const bf16x8 a0 = *(const LAS bf16x8*)(kT + (lane & 15) * 72 + 8 * (lane >> 4)), a1 = *(const LAS bf16x8*)(kT + (lane & 15) * 72 + 32 + 8 * (lane >> 4));
          const bf16x8 b0 = *(const LAS bf16x8*)(vT + (16 * wave + (lane & 15)) * 72 + 8 * (lane >> 4)), b1 = *(const LAS bf16x8*)(vT + (16 * wave + (lane & 15)) * 72 + 32 + 8 * (lane >> 4));
          acc = acc * decay;
          acc = __builtin_amdgcn_mfma_f32_16x16x32_bf16(a0, b0, acc, 0, 0, 0);
          acc = __builtin_amdgcn_mfma_f32_16x16x32_bf16(a1, b1, acc, 0, 0, 0);
          float ps = 0.f;
#pragma unroll
          for (int i = 0; i < 8; ++i) ps += __uint_as_float((unsigned)(unsigned short)a0[i] << 16) + __uint_as_float((unsigned)(unsigned short)a1[i] << 16);
          ps += __shfl_xor(ps, 16); ps += __shfl_xor(ps, 32);
          nst = decay * nst + ps; }
        m_prev = blast + M63;
    }
    __syncthreads();
}
constexpr int MO_QS = 0, MO_KS = 64 * 136 * 2, MO_VT = 2 * 64 * 136 * 2, MO_SP = MO_VT + 128 * 72 * 2, MO_TAB = MO_SP + 64 * 72 * 2;
__device__ __forceinline__ void mlstm_out_item(LAS unsigned char* lds, const bf16_t* __restrict__ Z, const float* __restrict__ gates, const float* __restrict__ conv_w, const float* __restrict__ conv_b,
                                               const float* __restrict__ gnorm, const bf16_t* __restrict__ CstT, const float* __restrict__ nprev, const float* __restrict__ mprev, bf16_t* ym, int bh, int c) {
    const int tid = threadIdx.x, lane = tid & 63, wave = __builtin_amdgcn_readfirstlane(tid >> 6);
    const int b = bh >> 2, h = bh & 3, chunk = bh * 32 + c;
    LAS bf16_t* qs = (LAS bf16_t*)(lds + MO_QS); LAS bf16_t* ksm = (LAS bf16_t*)(lds + MO_KS); LAS bf16_t* vT = (LAS bf16_t*)(lds + MO_VT); LAS bf16_t* Sp = (LAS bf16_t*)(lds + MO_SP);
    LAS float* gT = (LAS float*)(lds + MO_TAB); LAS float* MT = gT + 64; LAS float* aT = gT + 128; LAS float* emT = gT + 192; LAS float* denT = gT + 256; LAS float* ssqT = gT + 320;
    const float m_prev = mprev[chunk];
    const int s = tid >> 3, part = tid & 7; const size_t zrow = ((size_t)b * SEQ + c * 64 + s) * ZP;
#pragma unroll
    for (int hh = 0; hh < 2; ++hh) { float o[8]; const int ch = h * 128 + 16 * part + 8 * hh;
        conv8(Z + zrow + ch, c * 64 + s, conv_w, conv_b, ch, o);
        v4u w; w.x = pkbf(o[0], o[1]); w.y = pkbf(o[2], o[3]); w.z = pkbf(o[4], o[5]); w.w = pkbf(o[6], o[7]); *(LAS v4u*)(qs + s * 136 + 16 * part + 8 * hh) = w;
        conv8(Z + zrow + 512 + ch, c * 64 + s, conv_w, conv_b, 512 + ch, o);
        const float sc = 0.08838834764831845f;
        w.x = pkbf(o[0] * sc, o[1] * sc); w.y = pkbf(o[2] * sc, o[3] * sc); w.z = pkbf(o[4] * sc, o[5] * sc); w.w = pkbf(o[6] * sc, o[7] * sc); *(LAS v4u*)(ksm + s * 136 + 16 * part + 8 * hh) = w; }
    { const bf16_t* vsrc = Z + zrow + 1024 + h * 128 + 16 * part; const v4u r0 = *(const v4u*)vsrc, r1 = *(const v4u*)(vsrc + 8);
      LAS bf16_t* d = vT + (16 * part) * 72 + s;
      d[0 * 72] = (bf16_t)(r0.x & 0xffff); d[1 * 72] = (bf16_t)(r0.x >> 16); d[2 * 72] = (bf16_t)(r0.y & 0xffff); d[3 * 72] = (bf16_t)(r0.y >> 16);
      d[4 * 72] = (bf16_t)(r0.z & 0xffff); d[5 * 72] = (bf16_t)(r0.z >> 16); d[6 * 72] = (bf16_t)(r0.w & 0xffff); d[7 * 72] = (bf16_t)(r0.w >> 16);
      d[8 * 72] = (bf16_t)(r1.x & 0xffff); d[9 * 72] = (bf16_t)(r1.x >> 16); d[10 * 72] = (bf16_t)(r1.y & 0xffff); d[11 * 72] = (bf16_t)(r1.y >> 16);
      d[12 * 72] = (bf16_t)(r1.z & 0xffff); d[13 * 72] = (bf16_t)(r1.z >> 16); d[14 * 72] = (bf16_t)(r1.w & 0xffff); d[15 * 72] = (bf16_t)(r1.w >> 16); }
    if (wave == 0) { float bcum, g; chunk_gates(gates, b, h, c, lane, bcum, g);
        float pm = g;
#pragma unroll
        for (int o = 1; o < 64; o <<= 1) { const float t = __shfl_up(pm, o); if (lane >= o) pm = fmaxf(pm, t); }
        const float Mt = fmaxf(m_prev, pm);
        gT[lane] = g; MT[lane] = Mt; aT[lane] = expf(m_prev - Mt); emT[lane] = expf(-(bcum + Mt)); }
    bf16x8 cf[4];
    { const bf16_t* cp = CstT + ((size_t)chunk * 128 + 16 * wave + (lane & 15)) * 128 + 8 * (lane >> 4);
#pragma unroll
      for (int k = 0; k < 4; ++k) cf[k] = *(const bf16x8*)(cp + 32 * k); }
    __syncthreads();
    { const int mt = wave >> 1;
#pragma unroll
      for (int j = 0; j < 2; ++j) { const int nt = 2 * (wave & 1) + j; f32x4 sa = {0.f, 0.f, 0.f, 0.f};
#pragma unroll
        for (int k = 0; k < 4; ++k) { const bf16x8 a = *(const LAS bf16x8*)(qs + (16 * mt + (lane & 15)) * 136 + 32 * k + 8 * (lane >> 4)), bb = *(const LAS bf16x8*)(ksm + (16 * nt + (lane & 15)) * 136 + 32 * k + 8 * (lane >> 4));
            sa = __builtin_amdgcn_mfma_f32_16x16x32_bf16(a, bb, sa, 0, 0, 0); }
        const int sc = 16 * nt + (lane & 15); const float gs = gT[sc];
#pragma unroll
        for (int i = 0; i < 4; ++i) { const int tr = 16 * mt + 4 * (lane >> 4) + i; const float v = (sc <= tr) ? sa[i] * expf(gs - MT[tr]) : 0.f;
            Sp[tr * 72 + sc] = (bf16_t)(pkbf(v, 0.f) & 0xffff); } } }
    __syncthreads();
    { const v4u r = *(const LAS v4u*)(Sp + s * 72 + 8 * part);
      float ds = (bflo(r.x) + bfhi(r.x)) + (bflo(r.y) + bfhi(r.y)) + (bflo(r.z) + bfhi(r.z)) + (bflo(r.w) + bfhi(r.w));
      const float* np = nprev + (size_t)chunk * 128 + 16 * part; float qn = 0.f;
#pragma unroll
      for (int hh = 0; hh < 2; ++hh) { const v4u q = *(const LAS v4u*)(qs + s * 136 + 16 * part + 8 * hh); const f32x4 n0 = *(const f32x4*)(np + 8 * hh), n1 = *(const f32x4*)(np + 8 * hh + 4);
          qn += bflo(q.x) * n0[0] + bfhi(q.x) * n0[1] + bflo(q.y) * n0[2] + bfhi(q.y) * n0[3] + bflo(q.z) * n1[0] + bfhi(q.z) * n1[1] + bflo(q.w) * n1[2] + bfhi(q.w) * n1[3]; }
      ds += __shfl_xor(ds, 1); ds += __shfl_xor(ds, 2); ds += __shfl_xor(ds, 4);
      qn += __shfl_xor(qn, 1); qn += __shfl_xor(qn, 2); qn += __shfl_xor(qn, 4);
      if (part == 0) denT[s] = fmaxf(fabsf(aT[s] * qn + ds), emT[s]); }
    f32x4 num[4];
#pragma unroll
    for (int mt = 0; mt < 4; ++mt) { f32x4 a4 = {0.f, 0.f, 0.f, 0.f};
#pragma unroll
        for (int k = 0; k < 4; ++k) { const bf16x8 a = *(const LAS bf16x8*)(qs + (16 * mt + (lane & 15)) * 136 + 32 * k + 8 * (lane >> 4)); a4 = __builtin_amdgcn_mfma_f32_16x16x32_bf16(a, cf[k], a4, 0, 0, 0); }
#pragma unroll
        for (int i = 0; i < 4; ++i) a4[i] *= aT[16 * mt + 4 * (lane >> 4) + i];
#pragma unroll
        for (int k = 0; k < 2; ++k) { const bf16x8 a = *(const LAS bf16x8*)(Sp + (16 * mt + (lane & 15)) * 72 + 32 * k + 8 * (lane >> 4)), bb = *(const LAS bf16x8*)(vT + (16 * wave + (lane & 15)) * 72 + 32 * k + 8 * (lane >> 4));
            a4 = __builtin_amdgcn_mfma_f32_16x16x32_bf16(a, bb, a4, 0, 0, 0); }
        num[mt] = a4; }
    __syncthreads();
#pragma unroll
    for (int mt = 0; mt < 4; ++mt)
#pragma unroll
        for (int i = 0; i < 4; ++i) { const int tr = 16 * mt + 4 * (lane >> 4) + i; const float hv = num[mt][i] / denT[tr]; num[mt][i] = hv;
            float q = hv * hv; q += __shfl_xor(q, 1); q += __shfl_xor(q, 2); q += __shfl_xor(q, 4); q += __shfl_xor(q, 8);
            if ((lane & 15) == 0) ssqT[wave * 64 + tr] = q; }
    __syncthreads();
    { const int dv = h * 128 + 16 * wave + (lane & 15); const float gn = gnorm[dv];
#pragma unroll
      for (int mt = 0; mt < 4; ++mt)
#pragma unroll
        for (int i = 0; i < 4; ++i) { const int tr = 16 * mt + 4 * (lane >> 4) + i; float tot = 0.f;
#pragma unroll
            for (int w8 = 0; w8 < 8; ++w8) tot += ssqT[w8 * 64 + tr];
            const size_t row = (size_t)b * SEQ + c * 64 + tr; const float mo = __uint_as_float((unsigned)Z[row * ZP + 1536 + dv] << 16);
            const float y = num[mt][i] * rsqrtf(tot * (1.0f / 128.0f) + EPS) * gn * sigm(mo);
            ym[row * 512 + dv] = (bf16_t)(pkbf(y, 0.f) & 0xffff); } }
}
#define XB_TMO      128
#define XB_XCNT(j)  (256  + 64 * (j))
#define XB_XSUB(j)  (1280 + 64 * (j))
#define XB_XGEN(j)  (2304 + 64 * (j))
#define XB_TOP      3328
#define XB_TOPGEN   3392
#define XCD_BAR_WORDS 3456
#define XB_SPIN_CAP (1u << 18)

__device__ __forceinline__ unsigned xb_ld(unsigned* p)              { return __hip_atomic_load(p, __ATOMIC_RELAXED, __HIP_MEMORY_SCOPE_AGENT); }
__device__ __forceinline__ unsigned xb_add(unsigned* p, unsigned v) { return __hip_atomic_fetch_add(p, v, __ATOMIC_RELAXED, __HIP_MEMORY_SCOPE_AGENT); }
__device__ __forceinline__ unsigned xb_xcc_id() { return (unsigned)__builtin_amdgcn_s_getreg((3 << 11) | 20) & 0xFu; }
#define XB_SPIN(cond, bar) do { unsigned _sp = 0; while (cond) { __builtin_amdgcn_s_sleep(1); \
    if ((++_sp & 255u) == 0u) { if (xb_ld(&(bar)[XB_TMO])) break; if (_sp > XB_SPIN_CAP) { atomicAdd(&(bar)[XB_TMO], 1u); break; } } } } while (0)

struct XcdBarrier {
    unsigned* bar; unsigned x;
    volatile LAS unsigned* st;
};

__device__ __forceinline__ XcdBarrier xcd_barrier_post(unsigned* bar, volatile LAS unsigned* st) {
    XcdBarrier b; b.bar = bar; b.x = xb_xcc_id(); b.st = st;
    if (threadIdx.x == 0) (void)xb_add(&bar[XB_XCNT(b.x)], 1u);
    return b;
}
__device__ __forceinline__ void xcd_barrier_complete(unsigned* bar, unsigned x, unsigned& nloc, unsigned& nx) {
    const unsigned G = gridDim.x * gridDim.y * gridDim.z;
    unsigned sum, cnt, mine, sp = 0u;
    for (;;) {
        sum = 0u; cnt = 0u; mine = 0u;
#pragma unroll
        for (unsigned j = 0; j < 16; ++j) { const unsigned c = xb_ld(&bar[XB_XCNT(j)]); sum += c; cnt += (c > 0u) ? 1u : 0u; mine = (j == x) ? c : mine; }
        if (sum == G) break;
        __builtin_amdgcn_s_sleep(1);
        if ((++sp & 255u) == 0u) { if (xb_ld(&bar[XB_TMO])) break; if (sp > XB_SPIN_CAP) { atomicAdd(&bar[XB_TMO], 1u); break; } }
    }
    nloc = mine > 0u ? mine : 1u; nx = cnt > 0u ? cnt : 1u;
}

__device__ __forceinline__ void xcd_barrier(const XcdBarrier& b) {
    asm volatile("s_waitcnt vmcnt(0)" ::: "memory");
    __syncthreads();
    if (threadIdx.x == 0) {
        unsigned* bar = b.bar;
        __builtin_amdgcn_s_waitcnt(0);
        unsigned nloc = b.st[0], nx = b.st[1];
        if (nloc == 0u) { xcd_barrier_complete(bar, b.x, nloc, nx); b.st[0] = nloc; b.st[1] = nx; }
        const unsigned old = xb_add(&bar[XB_XSUB(b.x)], 1u);
        const unsigned gen = old / nloc;
        if (old + 1u == (gen + 1u) * nloc) {
            __builtin_amdgcn_fence(__ATOMIC_RELEASE, "agent");
            asm volatile("s_waitcnt vmcnt(0)" ::: "memory");
            const unsigned og = xb_add(&bar[XB_TOP], 1u);
            const unsigned tg = og / nx;
            if (og + 1u == (tg + 1u) * nx) xb_add(&bar[XB_TOPGEN], 1u);
            else XB_SPIN(xb_ld(&bar[XB_TOPGEN]) == tg, bar);
            __builtin_amdgcn_fence(__ATOMIC_ACQUIRE, "agent");
            xb_add(&bar[XB_XGEN(b.x)], 1u);
            asm volatile("s_waitcnt vmcnt(0)" ::: "memory");
        } else {
            XB_SPIN(xb_ld(&bar[XB_XGEN(b.x)]) == gen, bar);
            __builtin_amdgcn_fence(__ATOMIC_ACQUIRE, "agent");
            asm volatile("s_waitcnt vmcnt(0)" ::: "memory");
        }
    }
    __syncthreads();
}
__global__ void __launch_bounds__(NTHR, 2) fwd_mega(Args args) {
    extern __shared__ __attribute__((aligned(16))) unsigned char lds_raw[];
    LAS unsigned char* lds = (LAS unsigned char*)lds_raw;
    cg::grid_group grid = cg::this_grid();
    const int tid = threadIdx.x, lane = tid & 63, wave = __builtin_amdgcn_readfirstlane(tid >> 6);
    const int G = gridDim.x, bx = blockIdx.x;
    const int vcu = (G % 8 == 0) ? (bx % 8) * (G / 8) + bx / 8 : bx;
    const int gw = vcu * NWAVES + wave, NGW = G * NWAVES;
    unsigned char* ws = args.ws;
    const float* x = args.in[0]; const float* norm1_g = args.in[1]; const float* w_in = args.in[2]; const float* b_in = args.in[3];
    const float* conv_w = args.in[4]; const float* conv_b = args.in[5]; const float* mnorm_g = args.in[6]; const float* w_brm = args.in[7]; const float* w_brf = args.in[8];
    const float* w_out = args.in[9]; const float* norm2_g = args.in[10]; const float* w_gate = args.in[11]; const float* w_up = args.in[12]; const float* w_down = args.in[13]; const float* normf_g = args.in[14];
    float* out = args.out;
    float* rstd1 = (float*)(ws + WS_RSTD1); float* rss2 = (float*)(ws + WS_RSS2); float* rss3 = (float*)(ws + WS_RSS3); float* mprev = (float*)(ws + WS_MPREV);
    float* gates = (float*)(ws + WS_GATES); float* cumf = (float*)(ws + WS_CUMF); float* nprev = (float*)(ws + WS_NPREV);
    bf16_t* WinT = (bf16_t*)(ws + WS_WIN); bf16_t* WguT = (bf16_t*)(ws + WS_WGU); bf16_t* WdT = (bf16_t*)(ws + WS_WD); bf16_t* WbmT = (bf16_t*)(ws + WS_WBM); bf16_t* WbfT = (bf16_t*)(ws + WS_WBF); bf16_t* WoutT = (bf16_t*)(ws + WS_WOUT);
    bf16_t* XB = (bf16_t*)(ws + WS_XB); bf16_t* MIX = XB; bf16_t* Z = (bf16_t*)(ws + WS_Z); bf16_t* HB = (bf16_t*)(ws + WS_H); bf16_t* X1B = (bf16_t*)(ws + WS_X1B);
    bf16_t* YM = (bf16_t*)((unsigned char*)out + OUT_YM); bf16_t* YF = (bf16_t*)((unsigned char*)out + OUT_YF); bf16_t* CstT = (bf16_t*)((unsigned char*)out + OUT_CST);
    const int lo = args.ph_lo, hi = args.ph_hi;
#define IN(k) (lo <= (k) && (k) < hi)
#define SEAM(k) do { if (IN(k) && IN((k) + 1)) xcd_barrier(bar); } while (0)
    if (tid < 32) ((LAS unsigned*)(lds + MISC_OFF))[tid] = 0u;
    __syncthreads();
    XcdBarrier bar = xcd_barrier_post((unsigned*)ws, (volatile LAS unsigned*)(lds + MISC_OFF) + 8);
    if (hi - lo > 1) grid.sync();

    if (IN(0)) {
        for (int i = bx * NTHR + tid; i < T; i += G * NTHR) { rss2[i] = 0.f; rss3[i] = 0.f; }
        if (wave < 4) { for (int grp = vcu * 4 + wave; grp < T / 16; grp += G * 4) p0_row_group(x, norm1_g, w_in, b_in, XB, rstd1, gates, grp, lane); }
        LAS float* scr = (LAS float*)(lds + wave * 16384);
        constexpr int I_IN = 16 * 176, I_GU = 16 * 176, I_D = 44 * 32, I_BM = 8 * 32, I_BF = 8 * 32, I_O = 16 * 32;
        constexpr int NITEMS = I_IN + I_GU + I_D + I_BM + I_BF + I_O;
        for (int it = gw; it < NITEMS; it += NGW) {
            int r = it;
            if (r < I_IN) { const int kb = r / 176, nb = r % 176, d0 = 32 * nb; const int s0 = d0 + (d0 >= 2048 ? 8 : 0) + (d0 >= 3584 ? 8 : 0);
                p0_transpose_item(w_in, NIN, 1024, WinT, d0, s0, norm1_g, scr, kb, lane); continue; } r -= I_IN;
            if (r < I_GU) { const int kb = r / 176, nb = r % 176, d0 = 32 * nb; const int tile = d0 >> 8, within = d0 & 255; const int j0 = tile * 128 + (within & 127);
                p0_transpose_item((within < 128) ? w_gate : w_up, DFF, 1024, WguT, d0, j0, norm2_g, scr, kb, lane); continue; } r -= I_GU;
            if (r < I_D) { const int kb = r / 32, nb = r % 32; p0_transpose_item(w_down, 1024, DFF, WdT, 32 * nb, 32 * nb, nullptr, scr, kb, lane); continue; } r -= I_D;
            if (r < I_BM) { const int kb = r / 32, nb = r % 32; p0_transpose_item(w_brm, 1024, 512, WbmT, 32 * nb, 32 * nb, nullptr, scr, kb, lane); continue; } r -= I_BM;
            if (r < I_BF) { const int kb = r / 32, nb = r % 32; p0_transpose_item(w_brf, 1024, 512, WbfT, 32 * nb, 32 * nb, nullptr, scr, kb, lane); continue; } r -= I_BF;
            { const int kb = r / 32, nb = r % 32; p0_transpose_item(w_out, 1024, 1024, WoutT, 32 * nb, 32 * nb, nullptr, scr, kb, lane); }
        }
    }
    SEAM(0);
    if (IN(1)) {
        if (wave == 0 && vcu < 64) fox_cumsum(gates, cumf, vcu, lane);
        pg8::Gemm g{XB, WinT, T, ZP, 1024}; pg8::StaticOrder S; S.init(T, ZP, G, bx);
        pg8::EpiInProj E{Z, rstd1, b_in};
        pg8::gemm_phase<pg8::EpiInProj, pg8::StaticOrder, true, true>(lds, g, S, E);
    }
    SEAM(1);
    if (IN(2)) {
        const attn_body::AttnTensors AT{(const attn_body::bf16*)(Z + 2048), (const attn_body::bf16*)(Z + 2560), (const attn_body::bf16*)(Z + 3072), (attn_body::bf16*)YF, cumf};
        const attn_body::StaticOrder S(vcu);
        attn_body::attn_phase<attn_body::StaticOrder>((char*)lds_raw, AT, S);
        __syncthreads();
        for (int it = vcu; it < 256; it += G) mlstm_state_item(lds, Z, gates, conv_w, conv_b, CstT, nprev, mprev, it >> 3, it & 7);
    }
    SEAM(2);
    if (IN(3)) {
        for (int it = vcu * 4; it < 1024; it += G * 4)
            for (int j = 0; j < 4; ++j) mlstm_out_item(lds, Z, gates, conv_w, conv_b, mnorm_g, CstT, nprev, mprev, YM, (it + j) >> 5, (it + j) & 31);
        __syncthreads();
    }
    SEAM(3);
    if (IN(4)) {
        pg8::StaticOrder S; S.init(T, 1024, G, bx);
        { pg8::Gemm g{YM, WbmT, T, 1024, 512}; pg8::EpiBranch<0> E{MIX, Z}; pg8::gemm_phase<pg8::EpiBranch<0>, pg8::StaticOrder, true, true>(lds, g, S, E); }
        { pg8::Gemm g{YF, WbfT, T, 1024, 512}; pg8::EpiBranch<1> E{MIX, Z}; pg8::gemm_phase<pg8::EpiBranch<1>, pg8::StaticOrder, true, true>(lds, g, S, E); }
    }
    SEAM(4);
    if (IN(5)) {
        pg8::Gemm g{MIX, WoutT, T, 1024, 1024}; pg8::StaticOrder S; S.init(T, 1024, G, bx);
        pg8::EpiResid E{x, out, X1B, rss2};
        pg8::gemm_phase<pg8::EpiResid, pg8::StaticOrder, true, true>(lds, g, S, E);
    }
    SEAM(5);
    if (IN(6)) {
        pg8::Gemm g{X1B, WguT, T, 2 * DFF, 1024}; pg8::StaticOrder S; S.init(T, 2 * DFF, G, bx);
        pg8::EpiSwiglu E{HB, rss2};
        pg8::gemm_phase<pg8::EpiSwiglu, pg8::StaticOrder, true, true>(lds, g, S, E);
    }
    SEAM(6);
    if (IN(7)) {
        pg8::Gemm g{HB, WdT, T, 1024, DFF}; pg8::StaticOrder S; S.init(T, 1024, G, bx);
        pg8::EpiResid E{out, out, nullptr, rss3};
        pg8::gemm_phase<pg8::EpiResid, pg8::StaticOrder, true, true>(lds, g, S, E);
    }
    SEAM(7);
    if (IN(8)) {
        f32x4 gv[4];
#pragma unroll
        for (int j = 0; j < 4; ++j) gv[j] = *(const f32x4*)(normf_g + 256 * j + 4 * lane);
        for (int m = gw; m < T; m += NGW) { const float rs = rsqrtf(rss3[m] * (1.0f / DMODEL) + EPS); f32x4* o = (f32x4*)(out + (size_t)m * DMODEL) + lane;
#pragma unroll
            for (int j = 0; j < 4; ++j) o[64 * j] = o[64 * j] * rs * gv[j]; }
    }
#undef IN
#undef SEAM
}

#ifndef MK_SPLIT
#define MK_SPLIT 0
#endif
extern "C" void kernel_launch(void* const* d_in, const int* in_sizes, int n_in, void* d_out, int out_size, void* d_ws, size_t ws_size, hipStream_t stream) {
    static int grid = 0;
    if (grid == 0) {
        if (n_in != 15 || out_size != T * DMODEL || ws_size < WS_END) { fprintf(stderr, "kernel_launch: unexpected shapes (n_in %d out %d ws %zu)\n", n_in, out_size, ws_size); grid = -1; return; }
        int dev = 0, cus = 0, per_cu = 0;
        hipGetDevice(&dev); hipDeviceGetAttribute(&cus, hipDeviceAttributeMultiprocessorCount, dev);
        if (hipFuncSetAttribute((const void*)fwd_mega, hipFuncAttributeMaxDynamicSharedMemorySize, LDS_BYTES) != hipSuccess) { fprintf(stderr, "kernel_launch: hipFuncSetAttribute failed\n"); grid = -1; return; }
        if (hipOccupancyMaxActiveBlocksPerMultiprocessor(&per_cu, (const void*)fwd_mega, NTHR, LDS_BYTES) != hipSuccess || per_cu < 1) { fprintf(stderr, "kernel_launch: occupancy query says %d\n", per_cu); per_cu = 1; }
        (void)hipGetLastError();
        grid = cus * 1;
    }
    if (grid < 0) return;
    if (hipMemsetAsync(d_ws, 0, 16384, stream) != hipSuccess) { fprintf(stderr, "kernel_launch: memset failed\n"); return; }
    Args a{};
    for (int i = 0; i < 15; ++i) a.in[i] = (const float*)d_in[i];
    a.out = (float*)d_out; a.ws = (unsigned char*)d_ws;
#if MK_SPLIT
    for (int p = 0; p < 9; ++p) { a.ph_lo = p; a.ph_hi = p + 1; hipLaunchKernelGGL(fwd_mega, dim3(grid), dim3(NTHR), LDS_BYTES, stream, a); }
#else
    a.ph_lo = 0; a.ph_hi = 9;
    void* kargs[] = {&a};
    hipError_t e = hipLaunchCooperativeKernel((const void*)fwd_mega, dim3(grid), dim3(NTHR), kargs, LDS_BYTES, stream);
    if (e != hipSuccess) fprintf(stderr, "kernel_launch: cooperative launch failed: %s (grid %d)\n", hipGetErrorString(e), grid);
#endif
}
```

```cpp
#include <hip/hip_runtime.h>
#include <hip/hip_cooperative_groups.h>
#include <hip/hip_bf16.h>
#include <cstdio>
#include <cstdint>
#include <cmath>
namespace pg8 {
#define PG8_LAS __attribute__((address_space(3)))
typedef unsigned short bf16_t;
typedef short bf16x8 __attribute__((ext_vector_type(8)));
typedef float f32x4 __attribute__((ext_vector_type(4)));
typedef unsigned u32x4 __attribute__((ext_vector_type(4)));
constexpr int BM = 256, BK = 64, HALF = 128, HTB = HALF * BK * 2  , STAGE_BYTES = 8 * HTB, NXCD = 8, WGM = 8;

__host__ __device__ __forceinline__ int lds_byte(int r, int c) { const int st = (r >> 4) * 2 + (c >> 5), rr = r & 15, cc = c & 31, ob = rr * 64 + cc * 2; return st * 1024 + (ob ^ (((ob >> 9) & 1) << 5)); }
__host__ __device__ __forceinline__ void stage_rc(int b, int& R, int& C) { const int st = b / 1024, sb = b % 1024, swz = sb ^ (((sb >> 9) & 1) << 5); R = (st >> 1) * 16 + swz / 64; C = (st & 1) * 32 + (swz % 64) / 2; }
__host__ __device__ __forceinline__ int perm32(int rho) { const int n = rho >> 4, i = rho & 15; return 8 * (i >> 2) + 4 * n + (i & 3); }

struct Unit { int pm, pn; };
struct Gemm { const bf16_t* A; const bf16_t* Bt; int M, N, K; };

struct StaticOrder {
    int nM, nN, nwg, G, c;
    __host__ __device__ void init(int M, int N, int G_, int c_) { nM = M / BM; nN = N / BM; nwg = nM * nN; G = G_; c = c_; }
    __host__ __device__ bool next(int i, Unit& u) const {
        const long L = (long)i * G + c; if (L >= nwg) return false;
        int wgid = (int)L; { const int q = nwg / NXCD, r = nwg % NXCD, xcd = wgid % NXCD, off = wgid / NXCD; wgid = (xcd < r ? xcd * (q + 1) : r * (q + 1) + (xcd - r) * q) + off; }
        const int nig = WGM * nN, gid = wgid / nig, fm = gid * WGM, gsz = (nM - fm) < WGM ? (nM - fm) : WGM;
        u.pm = fm + ((wgid % nig) % gsz); u.pn = (wgid % nig) / gsz; return true;
    }
    __device__ __forceinline__ void a_ready(const Unit&) const {}
    __device__ __forceinline__ void done(const Unit&) const {}
};

__device__ __forceinline__ unsigned cvt_pk_bf16(float lo, float hi) { unsigned r; asm volatile("v_cvt_pk_bf16_f32 %0, %1, %2" : "=v"(r) : "v"(lo), "v"(hi)); return r; }
typedef float f32x2 __attribute__((ext_vector_type(2)));
typedef float f32x2 __attribute__((ext_vector_type(2))); typedef __bf16 bf16x2_t __attribute__((ext_vector_type(2)));
__device__ __forceinline__ unsigned pkbf(float lo, float hi) { f32x2 v = {lo, hi}; bf16x2_t b = __builtin_convertvector(v, bf16x2_t); return __builtin_bit_cast(unsigned, b); }
__device__ __forceinline__ float bflo(unsigned w) { return __uint_as_float(w << 16); }
__device__ __forceinline__ float bfhi(unsigned w) { return __uint_as_float(w & 0xffff0000u); }
__device__ __forceinline__ float sigm(float v) { return 1.0f / (1.0f + __expf(-v)); }
constexpr int ZP = 5632;
constexpr float ATT_C2 = 0.125f * 1.4426950408889634f;
constexpr float RMS_EPS = 1e-6f;
struct EpiInProj {
    static constexpr bool PERM = true, AFTER_DRAIN = false;
    bf16_t* Z; const float* rstd; const float* bias;
    __device__ __forceinline__ void operator()(const f32x4 (&acc)[2][2][4][2], const Unit& u, int wr, int wc, int fr, int fq) const {
        const int colt = u.pn * BM;
        const int srcoff = (colt >= 2048 ? 8 : 0) + (colt >= 3584 ? 8 : 0);
        const float sc = (colt >= 2048 && colt < 2560) ? ATT_C2 : 1.f;
        const int col0 = colt + wc * 32 + 8 * fq;
        f32x4 bv[2][2];
#pragma unroll
        for (int bj = 0; bj < 2; ++bj)
#pragma unroll
            for (int n = 0; n < 2; ++n) bv[bj][n] = *(const f32x4*)(bias + srcoff + col0 + bj * HALF + 4 * n);
#pragma unroll
        for (int ai = 0; ai < 2; ++ai)
#pragma unroll
            for (int m = 0; m < 4; ++m) { const int row = u.pm * BM + ai * HALF + wr * 64 + m * 16 + fr; const float rs = rstd[row]; bf16_t* rowp = Z + (size_t)row * ZP + col0;
#pragma unroll
                for (int bj = 0; bj < 2; ++bj) { const f32x4 v0 = (acc[ai][bj][m][0] * rs + bv[bj][0]) * sc, v1 = (acc[ai][bj][m][1] * rs + bv[bj][1]) * sc;
                    u32x4 w; w.x = pkbf(v0[0], v0[1]); w.y = pkbf(v0[2], v0[3]); w.z = pkbf(v1[0], v1[1]); w.w = pkbf(v1[2], v1[3]);
                    *(u32x4*)(rowp + bj * HALF) = w; } }
    }
};
template <int PASS> struct EpiBranch {
    static constexpr bool PERM = true, AFTER_DRAIN = false;
    bf16_t* mix; const bf16_t* Z;
    __device__ __forceinline__ void operator()(const f32x4 (&acc)[2][2][4][2], const Unit& u, int wr, int wc, int fr, int fq) const {
        const int col0 = u.pn * BM + wc * 32 + 8 * fq;
#pragma unroll
        for (int ai = 0; ai < 2; ++ai)
#pragma unroll
            for (int m = 0; m < 4; ++m) { const int row = u.pm * BM + ai * HALF + wr * 64 + m * 16 + fr;
                const bf16_t* gp = Z + (size_t)row * ZP + (PASS == 0 ? 3584 : 4608) + col0; bf16_t* mp = mix + (size_t)row * 1024 + col0;
#pragma unroll
                for (int bj = 0; bj < 2; ++bj) { const u32x4 g = *(const u32x4*)(gp + bj * HALF); const f32x4 a0 = acc[ai][bj][m][0], a1 = acc[ai][bj][m][1];
                    float v[8];
                    v[0] = sigm(bflo(g.x)) * a0[0]; v[1] = sigm(bfhi(g.x)) * a0[1]; v[2] = sigm(bflo(g.y)) * a0[2]; v[3] = sigm(bfhi(g.y)) * a0[3];
                    v[4] = sigm(bflo(g.z)) * a1[0]; v[5] = sigm(bfhi(g.z)) * a1[1]; v[6] = sigm(bflo(g.w)) * a1[2]; v[7] = sigm(bfhi(g.w)) * a1[3];
                    if (PASS == 1) { const u32x4 p = *(const u32x4*)(mp + bj * HALF);
                        v[0] += bflo(p.x); v[1] += bfhi(p.x); v[2] += bflo(p.y); v[3] += bfhi(p.y); v[4] += bflo(p.z); v[5] += bfhi(p.z); v[6] += bflo(p.w); v[7] += bfhi(p.w); }
                    u32x4 w; w.x = pkbf(v[0], v[1]); w.y = pkbf(v[2], v[3]); w.z = pkbf(v[4], v[5]); w.w = pkbf(v[6], v[7]);
                    *(u32x4*)(mp + bj * HALF) = w; } }
    }
};
struct EpiResid {
    static constexpr bool PERM = false, AFTER_DRAIN = false;
    const float* base; float* out; bf16_t* xb; float* rowss;
    __device__ __forceinline__ void operator()(const f32x4 (&acc)[2][2][4][2], const Unit& u, int wr, int wc, int fr, int fq) const {
        typedef unsigned u32x2v __attribute__((ext_vector_type(2)));
        const int col0 = u.pn * BM + wc * 32 + 4 * fq;
#pragma unroll
        for (int ai = 0; ai < 2; ++ai)
#pragma unroll
            for (int m = 0; m < 4; ++m) { const int row = u.pm * BM + ai * HALF + wr * 64 + m * 16 + fr; const size_t off = (size_t)row * 1024 + col0; float ss = 0.f;
#pragma unroll
                for (int bj = 0; bj < 2; ++bj)
#pragma unroll
                    for (int n = 0; n < 2; ++n) { const f32x4 o = *(const f32x4*)(base + off + bj * HALF + n * 16) + acc[ai][bj][m][n];
                        *(f32x4*)(out + off + bj * HALF + n * 16) = o; ss += (o[0] * o[0] + o[1] * o[1]) + (o[2] * o[2] + o[3] * o[3]);
                        if (xb) { u32x2v w; w.x = pkbf(o[0], o[1]); w.y = pkbf(o[2], o[3]); *(u32x2v*)(xb + off + bj * HALF + n * 16) = w; } }
                ss += __shfl_xor(ss, 16); ss += __shfl_xor(ss, 32);
                if (fq == 0) unsafeAtomicAdd(rowss + row, ss); }
    }
};
struct EpiSwiglu {
    static constexpr bool PERM = true, AFTER_DRAIN = false;
    bf16_t* H; const float* rowss;
    __device__ __forceinline__ void operator()(const f32x4 (&acc)[2][2][4][2], const Unit& u, int wr, int wc, int fr, int fq) const {
        const int col0 = u.pn * HALF + wc * 32 + 8 * fq;
#pragma unroll
        for (int ai = 0; ai < 2; ++ai)
#pragma unroll
            for (int m = 0; m < 4; ++m) { const int row = u.pm * BM + ai * HALF + wr * 64 + m * 16 + fr; const float rs = rsqrtf(rowss[row] * (1.0f / 1024.0f) + RMS_EPS);
                float v[8];
#pragma unroll
                for (int n = 0; n < 2; ++n)
#pragma unroll
                    for (int j = 0; j < 4; ++j) { const float g = acc[ai][0][m][n][j] * rs, up = acc[ai][1][m][n][j] * rs; v[4 * n + j] = g * sigm(g) * up; }
                u32x4 w; w.x = pkbf(v[0], v[1]); w.y = pkbf(v[2], v[3]); w.z = pkbf(v[4], v[5]); w.w = pkbf(v[6], v[7]);
                *(u32x4*)(H + (size_t)row * 2816 + col0) = w; }
    }
};
template <class Epi, class Sched, bool ALIGN_EPI = false, bool SP2 = false>
__device__ __forceinline__ void gemm_phase(PG8_LAS unsigned char* lds, const Gemm g, const Sched& S, const Epi& E) {
    const int tid = threadIdx.x, wid = __builtin_amdgcn_readfirstlane(tid >> 6), lane = tid & 63, wr = wid >> 2, wc = wid & 3, fr = lane & 15, fq = lane >> 4;
    const int K = g.K, nt = K / BK;
    unsigned voffA[2], voffB[2];
#pragma unroll
    for (int i = 0; i < 2; ++i) { int R, C; stage_rc(tid * 16 + i * 8192, R, C); const int Rb = Epi::PERM ? ((R & ~31) + perm32(R & 31)) : R;
        voffA[i] = (unsigned)(R * K + C) * 2u; voffB[i] = (unsigned)(Rb * K + C) * 2u; }
    const size_t kstep = (size_t)(BK * 2);
    const size_t hstep = (size_t)HALF * K * 2;
    const size_t tstep = 2 * hstep;
    const unsigned ldsw = (unsigned)wid * 1024u;
    const int aoff = lds_byte(wr * 64 + fr, fq * 8), boff = lds_byte(wc * 32 + fr, fq * 8);
#define PG8_SA(b, h) (((b) * 2 + (h)) * HTB)
#define PG8_SB(b, h) ((4 + (b) * 2 + (h)) * HTB)
#define PG8_STAGE(bufoff, gbase, voff) do { _Pragma("unroll") for (int _i = 0; _i < 2; ++_i) \
        __builtin_amdgcn_global_load_lds((const unsigned*)((const char*)(gbase) + (voff)[_i]), (PG8_LAS unsigned*)(lds + (bufoff) + ldsw + _i * 8192), 16, 0, 0); } while (0)
#define PG8_LDA(dst, b, h) do { _Pragma("unroll") for (int m = 0; m < 4; ++m) _Pragma("unroll") for (int k = 0; k < 2; ++k) dst[m][k] = *(const PG8_LAS bf16x8*)(lds + PG8_SA(b, h) + aoff + m * 2048 + k * 1024); } while (0)
#define PG8_LDB(dst, b, h) do { _Pragma("unroll") for (int n = 0; n < 2; ++n) _Pragma("unroll") for (int k = 0; k < 2; ++k) dst[n][k] = *(const PG8_LAS bf16x8*)(lds + PG8_SB(b, h) + boff + n * 2048 + k * 1024); } while (0)
#define PG8_MMA(ai, bj, At, Bt) do { __builtin_amdgcn_s_setprio(1); _Pragma("unroll") for (int m = 0; m < 4; ++m) _Pragma("unroll") for (int n = 0; n < 2; ++n) _Pragma("unroll") for (int k = 0; k < 2; ++k) \
        acc[ai][bj][m][n] = __builtin_amdgcn_mfma_f32_16x16x32_bf16(Bt[n][k], At[m][k], acc[ai][bj][m][n], 0, 0, 0); __builtin_amdgcn_s_setprio(0); } while (0)
#define PG8_WAIT_V(n) asm volatile("s_waitcnt vmcnt(" #n ")" ::: "memory")
#define PG8_WAIT_L(n) asm volatile("s_waitcnt lgkmcnt(" #n ")" ::: "memory")
#define PG8_BAR __builtin_amdgcn_s_barrier()
#define PG8_SCHED __builtin_amdgcn_sched_barrier(0)
    Unit cur, nxt; int ui = 0;
    if (!S.next(0, cur)) return;
    f32x4 acc[2][2][4][2];
#pragma unroll
    for (int a = 0; a < 2; ++a)
#pragma unroll
        for (int b = 0; b < 2; ++b)
#pragma unroll
            for (int m = 0; m < 4; ++m)
#pragma unroll
                for (int n = 0; n < 2; ++n) acc[a][b][m][n] = (f32x4){0.f, 0.f, 0.f, 0.f};
    bf16x8 At[4][2], B0[2][2], B1[2][2];
    const char* cA = (const char*)g.A + (size_t)cur.pm * tstep; const char* cB = (const char*)g.Bt + (size_t)cur.pn * tstep;
    S.a_ready(cur);
    if constexpr (SP2) {
        PG8_STAGE(PG8_SB(0, 0), cB, voffB); PG8_STAGE(PG8_SB(0, 1), cB + hstep, voffB); PG8_STAGE(PG8_SA(0, 0), cA, voffA); PG8_STAGE(PG8_SA(0, 1), cA + hstep, voffA);
        if (wr == 1) PG8_BAR;
        PG8_WAIT_V(2); PG8_BAR;
        PG8_STAGE(PG8_SB(1, 0), cB + kstep, voffB); PG8_STAGE(PG8_SA(1, 0), cA + kstep, voffA); PG8_STAGE(PG8_SB(1, 1), cB + hstep + kstep, voffB);
        PG8_WAIT_V(6); PG8_BAR;
    } else {
        PG8_STAGE(PG8_SB(0, 0), cB, voffB); PG8_STAGE(PG8_SA(0, 0), cA, voffA); PG8_STAGE(PG8_SB(0, 1), cB + hstep, voffB); PG8_STAGE(PG8_SA(0, 1), cA + hstep, voffA);
        if (wr == 1) PG8_BAR;
        PG8_WAIT_V(4); PG8_BAR;
        PG8_STAGE(PG8_SB(1, 0), cB + kstep, voffB); PG8_STAGE(PG8_SA(1, 0), cA + kstep, voffA); PG8_STAGE(PG8_SB(1, 1), cB + hstep + kstep, voffB);
        PG8_WAIT_V(6); PG8_BAR;
    }
    for (;;) {
        const bool has_next = S.next(ui + 1, nxt);
        const char* nA = has_next ? (const char*)g.A + (size_t)nxt.pm * tstep : cA; const char* nB = has_next ? (const char*)g.Bt + (size_t)nxt.pn * tstep : cB;
        for (int t = 0; t < nt; t += 2) {
            const bool last = (t == nt - 2);
            const char* a1 = cA + (size_t)(t + 1) * kstep;
            const char* a2 = last ? nA : cA + (size_t)(t + 2) * kstep; const char* b2 = last ? nB : cB + (size_t)(t + 2) * kstep;
            const char* a3 = a2 + kstep; const char* b3 = b2 + kstep;
            if (last && has_next) S.a_ready(nxt);
            if constexpr (SP2) {
            PG8_LDB(B0, 0, 0); PG8_LDB(B1, 0, 1); PG8_SCHED; PG8_LDA(At, 0, 0); PG8_STAGE(PG8_SA(1, 1), a1 + hstep, voffA);
            PG8_WAIT_V(8); PG8_WAIT_L(0); PG8_BAR; PG8_MMA(0, 0, At, B0); PG8_MMA(0, 1, At, B1); PG8_BAR; PG8_SCHED;
            PG8_LDA(At, 0, 1); PG8_STAGE(PG8_SB(0, 0), b2, voffB); PG8_STAGE(PG8_SB(0, 1), b2 + hstep, voffB); PG8_STAGE(PG8_SA(0, 0), a2, voffA);
            PG8_WAIT_V(8); PG8_WAIT_L(0); PG8_BAR; PG8_MMA(1, 0, At, B0); PG8_MMA(1, 1, At, B1); PG8_BAR; PG8_SCHED;
            PG8_LDB(B0, 1, 0); PG8_LDB(B1, 1, 1); PG8_SCHED; PG8_LDA(At, 1, 0); PG8_STAGE(PG8_SA(0, 1), a2 + hstep, voffA);
            PG8_WAIT_V(8); PG8_WAIT_L(0); PG8_BAR; PG8_MMA(0, 0, At, B0); PG8_MMA(0, 1, At, B1); PG8_BAR; PG8_SCHED;
            PG8_LDA(At, 1, 1); PG8_STAGE(PG8_SB(1, 0), b3, voffB); PG8_STAGE(PG8_SB(1, 1), b3 + hstep, voffB); PG8_STAGE(PG8_SA(1, 0), a3, voffA);
            PG8_WAIT_V(8); PG8_WAIT_L(0); PG8_BAR; PG8_MMA(1, 0, At, B0); PG8_MMA(1, 1, At, B1); PG8_BAR; PG8_SCHED;
            } else {
            PG8_LDB(B0, 0, 0); PG8_SCHED; PG8_LDA(At, 0, 0); PG8_STAGE(PG8_SA(1, 1), a1 + hstep, voffA);
            PG8_WAIT_L(8); PG8_BAR; PG8_WAIT_L(0); PG8_MMA(0, 0, At, B0); PG8_BAR; PG8_SCHED;
            PG8_LDB(B1, 0, 1); PG8_STAGE(PG8_SB(0, 0), b2, voffB);
            PG8_BAR; PG8_WAIT_L(0); PG8_MMA(0, 1, At, B1); PG8_BAR;
            PG8_LDA(At, 0, 1); PG8_STAGE(PG8_SA(0, 0), a2, voffA);
            PG8_BAR; PG8_WAIT_L(0); PG8_MMA(1, 0, At, B0); PG8_BAR; PG8_SCHED;
            PG8_STAGE(PG8_SB(0, 1), b2 + hstep, voffB);
            PG8_WAIT_V(6); PG8_BAR; PG8_MMA(1, 1, At, B1); PG8_BAR;
            PG8_LDB(B0, 1, 0); PG8_SCHED; PG8_LDA(At, 1, 0); PG8_STAGE(PG8_SA(0, 1), a2 + hstep, voffA);
            PG8_WAIT_L(8); PG8_BAR; PG8_WAIT_L(0); PG8_MMA(0, 0, At, B0); PG8_BAR; PG8_SCHED;
            PG8_LDB(B1, 1, 1); PG8_STAGE(PG8_SB(1, 0), b3, voffB);
            PG8_BAR; PG8_WAIT_L(0); PG8_MMA(0, 1, At, B1); PG8_BAR;
            PG8_LDA(At, 1, 1); PG8_STAGE(PG8_SA(1, 0), a3, voffA);
            PG8_BAR; PG8_WAIT_L(0); PG8_MMA(1, 0, At, B0); PG8_BAR; PG8_SCHED;
            PG8_STAGE(PG8_SB(1, 1), b3 + hstep, voffB);
            PG8_WAIT_V(6); PG8_BAR; PG8_MMA(1, 1, At, B1); PG8_BAR;
            }
        }
        if constexpr (ALIGN_EPI) { if (wr == 0) PG8_BAR; }
        if constexpr (!Epi::AFTER_DRAIN) { E(acc, cur, wr, wc, fr, fq); S.done(cur); }
        if (!has_next) break;
#pragma unroll
        for (int a = 0; a < 2; ++a)
#pragma unroll
            for (int b = 0; b < 2; ++b)
#pragma unroll
                for (int m = 0; m < 4; ++m)
#pragma unroll
                    for (int n = 0; n < 2; ++n) acc[a][b][m][n] = (f32x4){0.f, 0.f, 0.f, 0.f};
        cur = nxt; cA = nA; cB = nB; ++ui;
        if constexpr (ALIGN_EPI) { if (wr == 1) PG8_BAR; }
    }
    PG8_WAIT_V(0);
    if constexpr (!ALIGN_EPI) { if (wr == 0) PG8_BAR; }
    PG8_BAR;
    if constexpr (Epi::AFTER_DRAIN) { E.fused(acc, cur, wr, wc, fr, fq, lds, wid, lane); S.done(cur); }
#undef PG8_SA
#undef PG8_SB
#undef PG8_STAGE
#undef PG8_LDA
#undef PG8_LDB
#undef PG8_MMA
#undef PG8_WAIT_V
#undef PG8_WAIT_L
#undef PG8_BAR
#undef PG8_SCHED
}
}
namespace attn_body {
using bf16=__hip_bfloat16;
using bf16x8=__attribute__((ext_vector_type(8)))short;
using s16x4=__attribute__((ext_vector_type(4)))short;
using f32x16=__attribute__((ext_vector_type(16)))float;
using u32x4=__attribute__((ext_vector_type(4)))unsigned;
constexpr int BATCH=8,NHEAD=8,SEQ=2048,D=64,QP=5632,OP=512;
constexpr int NW=8,QBLK=32,QB=QBLK*NW,KVBLK=64,NQB=SEQ/QB;
constexpr int ATTN_UNIT_ROWS=QB;
__device__ __forceinline__ int crow(int r,int hi){return (r&3)+8*(r>>2)+4*hi;}
#define SBAR() __builtin_amdgcn_sched_barrier(0)
__device__ __forceinline__ void cmask(f32x16&p0,f32x16&p1,int jb,int qrel,int hi){
  const float NEG=-INFINITY; int kb=64*jb+4*hi;
  #pragma unroll
  for(int r=0;r<16;++r){int kv=kb+(r&3)+8*(r>>2); if(kv>qrel)p0[r]=NEG; if(kv+32>qrel)p1[r]=NEG;}
}

constexpr int NSLOT=3, SLOTB=8192;
constexpr int LDS_K=0, LDS_V=NSLOT*SLOTB, LDS_WS=2*NSLOT*SLOTB, LDS_OST=LDS_WS+NW*64*4, LDS_KB=LDS_OST+NW*4096, LDS_BYTES=LDS_KB+SEQ*4;
constexpr float C2=0.125f*1.4426950408889634f;
__device__ __forceinline__ void glds16(const void*gsrc,unsigned lds_dst){unsigned keep;
  asm volatile("s_mov_b32 %0, m0\n\ts_mov_b32 m0, %2\n\ts_nop 0\n\tglobal_load_lds_dwordx4 %1, off\n\ts_mov_b32 m0, %0":"=&s"(keep):"v"(gsrc),"s"(lds_dst):"memory");}
__device__ __forceinline__ float max3f(float a,float b,float c){float r;asm("v_max3_f32 %0, %1, %2, %3":"=v"(r):"v"(a),"v"(b),"v"(c));return r;}
__device__ __forceinline__ float max2f(float a,float b){float r;asm("v_max_f32_e32 %0, %1, %2":"=v"(r):"v"(a),"v"(b));return r;}
__device__ __forceinline__ float fadd_s(float a,float b){float r;asm("v_add_f32_e32 %0, %1, %2":"=v"(r):"v"(a),"v"(b));return r;}
__device__ __forceinline__ float fsub_s(float a,float b){float r;asm("v_sub_f32_e32 %0, %1, %2":"=v"(r):"v"(a),"v"(b));return r;}
typedef float f32x2_t __attribute__((ext_vector_type(2))); typedef __bf16 bf16x2_t __attribute__((ext_vector_type(2)));
__device__ __forceinline__ unsigned cvtpk_s(float lo,float hi){f32x2_t v={lo,hi};bf16x2_t b=__builtin_convertvector(v,bf16x2_t);return __builtin_bit_cast(unsigned,b);}
#define WAIT_BAR(N) asm volatile("s_waitcnt vmcnt(" #N ") lgkmcnt(0)\n\ts_barrier":::"memory")

__device__ __forceinline__ void qkt(f32x16&p0,f32x16&p1,const char*Kslot,const bf16x8*qr,const f32x16&i0,const f32x16&i1,int r32,int hi){
  const char*kb=Kslot+hi*1024+r32*16;
  #pragma unroll
  for(int d0=0;d0<4;++d0){
    const bf16x8 b0=*reinterpret_cast<const bf16x8*>(kb+d0*2048);
    const bf16x8 b1=*reinterpret_cast<const bf16x8*>(kb+d0*2048+512);
    if(d0==0){p0=__builtin_amdgcn_mfma_f32_32x32x16_bf16(b0,qr[0],i0,0,0,0);p1=__builtin_amdgcn_mfma_f32_32x32x16_bf16(b1,qr[0],i1,0,0,0);}
    else{p0=__builtin_amdgcn_mfma_f32_32x32x16_bf16(b0,qr[d0],p0,0,0,0);p1=__builtin_amdgcn_mfma_f32_32x32x16_bf16(b1,qr[d0],p1,0,0,0);}}
}
typedef __attribute__((address_space(3))) const char* lds_cptr;
typedef short v4i16_t __attribute__((ext_vector_type(4)));
__device__ __forceinline__ void kload8(bf16x8*kf,lds_cptr kp){
  kf[0]=*(const __attribute__((address_space(3))) bf16x8*)(kp);      kf[1]=*(const __attribute__((address_space(3))) bf16x8*)(kp+512);
  kf[2]=*(const __attribute__((address_space(3))) bf16x8*)(kp+2048); kf[3]=*(const __attribute__((address_space(3))) bf16x8*)(kp+2560);
  kf[4]=*(const __attribute__((address_space(3))) bf16x8*)(kp+4096); kf[5]=*(const __attribute__((address_space(3))) bf16x8*)(kp+4608);
  kf[6]=*(const __attribute__((address_space(3))) bf16x8*)(kp+6144); kf[7]=*(const __attribute__((address_space(3))) bf16x8*)(kp+6656);
}
__device__ __forceinline__ void kload2(bf16x8*kf,lds_cptr kp,int j){ kf[2*j]=*(const __attribute__((address_space(3))) bf16x8*)(kp+j*2048); kf[2*j+1]=*(const __attribute__((address_space(3))) bf16x8*)(kp+j*2048+512); }
__device__ __forceinline__ s16x4 vtr(lds_cptr p){ return __builtin_bit_cast(s16x4,__builtin_amdgcn_ds_read_tr16_b64_v4i16((__attribute__((address_space(3))) v4i16_t*)p)); }
__device__ __forceinline__ float rowmax(const f32x16&p0,const f32x16&p1){
  float a=max3f(p0[0],p0[1],p1[0]),b=max3f(p0[2],p0[3],p1[1]);a=max3f(a,p1[2],p1[3]);
  #pragma unroll
  for(int r=4;r<16;r+=4){a=max3f(a,p0[r],p0[r+1]);b=max3f(b,p0[r+2],p0[r+3]);a=max3f(a,p1[r],p1[r+1]);b=max3f(b,p1[r+2],p1[r+3]);}
  const float m=max2f(a,b);
  auto rr=__builtin_amdgcn_permlane32_swap(__float_as_uint(m),__float_as_uint(m),false,false);
  return max2f(__uint_as_float(rr[0]),__uint_as_float(rr[1]));
}
__device__ __forceinline__ void pv(f32x16*o,int vb,bf16x8 pa0,bf16x8 pa1,bf16x8 pa2,bf16x8 pa3){
  #pragma unroll
  for(int d0=0;d0<2;++d0){s16x4 lo[4],hi[4];
    #pragma unroll
    for(int ks=0;ks<4;++ks){
      asm volatile("ds_read_b64_tr_b16 %0,%1 offset:%c2":"=&v"(lo[ks]):"v"(vb),"i"(d0*4096+ks*1024):"memory");
      asm volatile("ds_read_b64_tr_b16 %0,%1 offset:%c2":"=&v"(hi[ks]):"v"(vb),"i"(d0*4096+ks*1024+512):"memory");}
    asm volatile("s_waitcnt lgkmcnt(0)":::"memory");SBAR();
    #define PK(k) (bf16x8){lo[k][0],lo[k][1],lo[k][2],lo[k][3],hi[k][0],hi[k][1],hi[k][2],hi[k][3]}
    o[d0]=__builtin_amdgcn_mfma_f32_32x32x16_bf16(pa0,PK(0),o[d0],0,0,0);
    o[d0]=__builtin_amdgcn_mfma_f32_32x32x16_bf16(pa1,PK(1),o[d0],0,0,0);
    o[d0]=__builtin_amdgcn_mfma_f32_32x32x16_bf16(pa2,PK(2),o[d0],0,0,0);
    o[d0]=__builtin_amdgcn_mfma_f32_32x32x16_bf16(pa3,PK(3),o[d0],0,0,0);
    #undef PK
  }
}

#ifndef ATTN_STORE16
#define ATTN_STORE16(p,v) (*(u32x4*)(p)=(v))
#endif
template<int THRL> __device__ __forceinline__ void attn_unit(int b,int h,int qb,const bf16*Q,const bf16*__restrict__ K,const bf16*__restrict__ V,bf16*O,const float*__restrict__ cum,char*shm){
  const int tid=threadIdx.x,lane=tid&63,r32=lane&31,hi=lane>>5; const int wid=__builtin_amdgcn_readfirstlane(tid>>6);
  const long rowbase=(long)b*SEQ; const int q0=qb*QB;
  {
    __attribute__((address_space(3))) float* kbw=(__attribute__((address_space(3))) float*)((__attribute__((address_space(3))) char*)shm+LDS_KB);
    const float cref=cum[q0];
    for(int i=tid;i<q0+QB;i+=NW*64) kbw[i]=(cref-cum[i])*1.4426950408889634f; }
  const bf16*Qw=Q+(rowbase+q0+wid*QBLK)*QP+h*D;
  const bf16*Kh=K+rowbase*QP+h*D,*Vh=V+rowbase*QP+h*D;
  const unsigned lds0=(unsigned)(uintptr_t)shm;
  float*wsf=(float*)(shm+LDS_WS)+wid*64;
  const bf16*ksrc=Kh+(long)lane*QP+wid*8;
  const bf16*vsrc=Vh+(long)(16*(wid&3)+(lane>>2))*QP+(wid>>2)*32+(lane&3)*8;
  const unsigned kdst=lds0+LDS_K+wid*1024, vdst=lds0+LDS_V+wid*1024;
  #define DMA_K(t,slot) glds16(ksrc+(long)(t)*KVBLK*QP,(unsigned)__builtin_amdgcn_readfirstlane(kdst+(slot)))
  #define DMA_V(t,slot) glds16(vsrc+(long)(t)*KVBLK*QP,(unsigned)__builtin_amdgcn_readfirstlane(vdst+(slot)))
  const int vb0=(int)(lds0+LDS_V)+((lane>>4)&1)*32+(lane&3)*8+(4*hi+((lane&15)>>2))*64;
  const char*Kbase=shm+LDS_K; bf16x8 kf[8];
  const lds_cptr shm3=(lds_cptr)shm; const lds_cptr kp0=shm3+LDS_K+hi*1024+r32*16; const lds_cptr vp0=shm3+LDS_V+((lane>>4)&1)*32+(lane&3)*8+(4*hi+((lane&15)>>2))*64;
  const int NT=(q0+QB)/KVBLK;
  DMA_K(0,0);DMA_V(0,0);DMA_K(1,SLOTB);
  bf16x8 qr[4];
  #pragma unroll
  for(int d0=0;d0<4;++d0)qr[d0]=*reinterpret_cast<const bf16x8*>(&Qw[(long)r32*QP+d0*16+hi*8]);
  float mhat=0.f,l_reg=0.f;f32x16 o[2];o[0]=f32x16{};o[1]=f32x16{};
  const int qrel=wid*QBLK+r32;
  #define CMASK(P0,P1,t) do{int jb_=(t)-(NT-4); if(jb_>=0)cmask(P0,P1,jb_,qrel,hi);}while(0)
  typedef float kbf4 __attribute__((ext_vector_type(4)));
  const __attribute__((address_space(3))) float* kbr=(const __attribute__((address_space(3))) float*)(shm3+LDS_KB)+4*hi;
  #define INITB1(P0,t,OFF) do{ const __attribute__((address_space(3))) float* kb_=kbr+64*(t)+(OFF); \
    _Pragma("unroll") for(int g_=0;g_<4;++g_){ const kbf4 b0_=*(const __attribute__((address_space(3))) kbf4*)(kb_+8*g_); \
      P0[4*g_]=b0_.x-mhat; P0[4*g_+1]=b0_.y-mhat; P0[4*g_+2]=b0_.z-mhat; P0[4*g_+3]=b0_.w-mhat; } }while(0)
  #define INITB(P0,P1,t) do{ INITB1(P0,t,0); INITB1(P1,t,32); }while(0)
  bool resc=false;
  #define START(P0,P1) do{ const float rm=rowmax(P0,P1); resc=false; \
    { const float dl=rm; mhat=fadd_s(mhat,dl); \
      _Pragma("unroll") for(int r=0;r<16;++r){P0[r]=fsub_s(P0[r],dl);P1[r]=fsub_s(P1[r],dl);} \
      } \
    _Pragma("unroll") for(int r=0;r<16;++r)P0[r]=__builtin_amdgcn_exp2f(P0[r]); }while(0)
  #define RESC() do{ if(resc){ asm volatile("s_waitcnt lgkmcnt(0)":::"memory"); \
      _Pragma("unroll") for(int d_=0;d_<2;++d_) _Pragma("unroll") for(int r=0;r<16;++r)o[d_][r]*=wsf[crow(r,hi)]; } }while(0)
  f32x16 pA0,pA1,pB0,pB1;
  int sl_prev=0,sl_cur=0,sl_next=SLOTB;
  #define ROT() do{sl_prev=sl_cur;sl_cur=sl_next;sl_next=(sl_next==(NSLOT-1)*SLOTB)?0:sl_next+SLOTB;}while(0)
  DMA_K(2,2*SLOTB);
  WAIT_BAR(3);
  INITB(pA0,pA1,0); qkt(pA0,pA1,Kbase,qr,pA0,pA1,r32,hi);asm volatile("s_nop 15\n\ts_nop 7":"+v"(pA0),"+v"(pA1));CMASK(pA0,pA1,0);
  START(pA0,pA1);
  _Pragma("unroll") for(int r=0;r<16;++r)pA1[r]=__builtin_amdgcn_exp2f(pA1[r]);
  WAIT_BAR(0);
  DMA_K(3,0);DMA_V(1,SLOTB);
  ROT();
  kload8(kf,kp0+sl_cur);
  WAIT_BAR(2);
  s16x4 vlo[8],vhi[8]; u32x4 pw0,pw1,pw2,pw3;
  #define PKW(P,B) cvtpk_s(P[B],P[B+1])
  #define PAF(k) __builtin_bit_cast(bf16x8,pw##k)
  #define VFR(i) (bf16x8){vlo[i][0],vlo[i][1],vlo[i][2],vlo[i][3],vhi[i][0],vhi[i][1],vhi[i][2],vhi[i][3]}
  #define PIN(x) asm volatile("":"+v"(x))
  #define MX3(a,b,c) __builtin_fmaxf(__builtin_fmaxf((a),(b)),(c))
  #define GAPA(MF,A0,A1,A2,A3,W0,W1,PW) do{ MF; sacc+=A0; sacc+=A1; sacc+=A2; sacc+=A3; PIN(sacc); W0; W1; PIN(PW); SBAR(); }while(0)
  #define EX(v) __builtin_amdgcn_exp2f(v)
  #define GAPB(MF,X,B) do{ MF; X[B]=EX(X[B]); X[B+1]=EX(X[B+1]); X[B+2]=EX(X[B+2]); X[B+3]=EX(X[B+3]); PIN(X); SBAR(); }while(0)
  #define VRD(i) do{ vlo[i]=vtr(vp_+(((i)>>2)*4096+((i)&3)*1024)); vhi[i]=vtr(vp_+(((i)>>2)*4096+((i)&3)*1024+512)); }while(0)
  #define KRD(G,j) do{ if(G){ kload2(kf,kp0+sl_next,j); SBAR(); } }while(0)
  #define STEP(C0,C1,P0,P1,t,GK,GV,GL) do{ SBAR(); INITB1(C0,t,0); SBAR(); \
    const lds_cptr vp_=vp0+sl_prev; \
    VRD(0); SBAR(); float sacc=(P0[0]+P0[1]); \
    GAPA(C0=__builtin_amdgcn_mfma_f32_32x32x16_bf16(kf[0],qr[0],C0,0,0,0), P0[2],P0[3],P0[4],P0[5],     pw0[0]=PKW(P0,0), pw0[1]=PKW(P0,2), pw0); \
    VRD(4); INITB1(C1,t,32); SBAR(); GAPA(C1=__builtin_amdgcn_mfma_f32_32x32x16_bf16(kf[1],qr[0],C1,0,0,0), P0[6],P0[7],P0[8],P0[9],     pw0[2]=PKW(P0,4), pw0[3]=PKW(P0,6), pw0); \
    VRD(1); SBAR(); GAPA(C0=__builtin_amdgcn_mfma_f32_32x32x16_bf16(kf[2],qr[1],C0,0,0,0),   P0[10],P0[11],P0[12],P0[13], pw1[0]=PKW(P0,8), pw1[1]=PKW(P0,10), pw1); \
    VRD(5); SBAR(); GAPA(C1=__builtin_amdgcn_mfma_f32_32x32x16_bf16(kf[3],qr[1],C1,0,0,0),   P0[14],P0[15],P1[0],P1[1],   pw1[2]=PKW(P0,12),pw1[3]=PKW(P0,14), pw1); \
    VRD(2); SBAR(); GAPA(C0=__builtin_amdgcn_mfma_f32_32x32x16_bf16(kf[4],qr[2],C0,0,0,0),   P1[2],P1[3],P1[4],P1[5],     pw2[0]=PKW(P1,0), pw2[1]=PKW(P1,2), pw2); \
    VRD(6); SBAR(); GAPA(C1=__builtin_amdgcn_mfma_f32_32x32x16_bf16(kf[5],qr[2],C1,0,0,0),   P1[6],P1[7],P1[8],P1[9],     pw2[2]=PKW(P1,4), pw2[3]=PKW(P1,6), pw2); \
    VRD(3); SBAR(); GAPA(C0=__builtin_amdgcn_mfma_f32_32x32x16_bf16(kf[6],qr[3],C0,0,0,0),   P1[10],P1[11],P1[12],P1[13], pw3[0]=PKW(P1,8), pw3[1]=PKW(P1,10), pw3); \
    VRD(7); SBAR(); GAPA(C1=__builtin_amdgcn_mfma_f32_32x32x16_bf16(kf[7],qr[3],C1,0,0,0),   P1[14],P1[15],0.f,0.f,       pw3[2]=PKW(P1,12),pw3[3]=PKW(P1,14), pw3); \
    l_reg+=sacc; \
    if(GK){DMA_K((t)+3,sl_cur);} if(GV){DMA_V((t)+1,sl_next);} \
    CMASK(C0,C1,t); \
    { float a=MX3(C0[0],C0[1],C1[0]),b=MX3(C0[2],C0[3],C1[1]); a=MX3(a,C1[2],C1[3]); \
      _Pragma("unroll") for(int r=4;r<16;r+=4){a=MX3(a,C0[r],C0[r+1]);b=MX3(b,C0[r+2],C0[r+3]);a=MX3(a,C1[r],C1[r+1]);b=MX3(b,C1[r+2],C1[r+3]);} \
      float rm=__builtin_fmaxf(a,b); { auto rr=__builtin_amdgcn_permlane32_swap(__float_as_uint(rm),__float_as_uint(rm),false,false); rm=__builtin_fmaxf(__uint_as_float(rr[0]),__uint_as_float(rr[1])); } \
      resc=false; \
      if(__builtin_expect(__any(rm>(float)THRL),0)){ const float dl=__builtin_fmaxf(rm,0.f); mhat+=dl; \
        _Pragma("unroll") for(int r=0;r<16;++r){C0[r]-=dl;C1[r]-=dl;} \
        const float f=__builtin_amdgcn_exp2f(-dl); l_reg*=f; if(hi==0)wsf[r32]=f; resc=true; } } \
    SBAR(); \
    GAPB(o[0]=__builtin_amdgcn_mfma_f32_32x32x16_bf16(PAF(0),VFR(0),o[0],0,0,0), C0,0); \
    GAPB(o[1]=__builtin_amdgcn_mfma_f32_32x32x16_bf16(PAF(0),VFR(4),o[1],0,0,0), C0,4); \
    KRD(GL,0); GAPB(o[0]=__builtin_amdgcn_mfma_f32_32x32x16_bf16(PAF(1),VFR(1),o[0],0,0,0), C0,8); \
    KRD(GL,1); GAPB(o[1]=__builtin_amdgcn_mfma_f32_32x32x16_bf16(PAF(1),VFR(5),o[1],0,0,0), C0,12); \
    KRD(GL,2); GAPB(o[0]=__builtin_amdgcn_mfma_f32_32x32x16_bf16(PAF(2),VFR(2),o[0],0,0,0), C1,0); \
    KRD(GL,3); GAPB(o[1]=__builtin_amdgcn_mfma_f32_32x32x16_bf16(PAF(2),VFR(6),o[1],0,0,0), C1,4); \
    GAPB(o[0]=__builtin_amdgcn_mfma_f32_32x32x16_bf16(PAF(3),VFR(3),o[0],0,0,0), C1,8); \
    GAPB(o[1]=__builtin_amdgcn_mfma_f32_32x32x16_bf16(PAF(3),VFR(7),o[1],0,0,0), C1,12); \
    }while(0)
  int t=1;
  #undef CMASK
  #define CMASK(P0,P1,t) do{}while(0)
  for(;t+5<NT;t+=2){
    STEP(pB0,pB1,pA0,pA1,t,true,true,true);     WAIT_BAR(2); RESC(); ROT();
    STEP(pA0,pA1,pB0,pB1,t+1,true,true,true);   WAIT_BAR(2); RESC(); ROT();
  }
  #undef CMASK
  #define CMASK(P0,P1,t) do{int jb_=(t)-(NT-4); if(jb_>=0)cmask(P0,P1,jb_,qrel,hi);}while(0)
  #define ENDW(tt) do{ if((tt)+3<NT){WAIT_BAR(2);} else if((tt)+2<NT){WAIT_BAR(1);} else {WAIT_BAR(0);} }while(0)
  for(;t+1<NT;t+=2){
    STEP(pB0,pB1,pA0,pA1,t,(t+3<NT),(t+1<NT),(t+1<NT));       ENDW(t);   RESC(); ROT();
    STEP(pA0,pA1,pB0,pB1,t+1,(t+4<NT),(t+2<NT),(t+2<NT));     ENDW(t+1); RESC(); ROT();
  }
  STEP(pB0,pB1,pA0,pA1,NT-1,false,false,false); RESC();
  { float sacc=pB0[0]+pB0[1]; _Pragma("unroll") for(int r=2;r<16;++r)sacc+=pB0[r]; _Pragma("unroll") for(int r=0;r<16;++r)sacc+=pB1[r]; l_reg+=sacc;
    pw0=(u32x4){PKW(pB0,0),PKW(pB0,2),PKW(pB0,4),PKW(pB0,6)};pw1=(u32x4){PKW(pB0,8),PKW(pB0,10),PKW(pB0,12),PKW(pB0,14)};pw2=(u32x4){PKW(pB1,0),PKW(pB1,2),PKW(pB1,4),PKW(pB1,6)};pw3=(u32x4){PKW(pB1,8),PKW(pB1,10),PKW(pB1,12),PKW(pB1,14)};
    SBAR(); pv(o,vb0+sl_cur,PAF(0),PAF(1),PAF(2),PAF(3)); }
  #undef PKW
  #undef PAF
  #undef VFR
  #undef PIN
  #undef MX3
  #undef GAPA
  #undef GAPB
  #undef EX
  #undef VRD
  #undef KRD
  #undef STEP
  #undef ENDW
  {auto rr=__builtin_amdgcn_permlane32_swap(__float_as_uint(l_reg),__float_as_uint(l_reg),false,false);l_reg=__uint_as_float(rr[0])+__uint_as_float(rr[1]);}
  if(hi==0)wsf[32+r32]=l_reg;asm volatile("s_waitcnt lgkmcnt(0)":::"memory");
  float rli[16];
  #pragma unroll
  for(int r=0;r<16;++r)rli[r]=__builtin_amdgcn_rcpf(wsf[32+crow(r,hi)]);
  bf16*Ow=O+(rowbase+q0+wid*QBLK)*OP+h*D;
  { bf16*stg=(bf16*)(shm+LDS_OST)+wid*2048;
    #pragma unroll
    for(int r=0;r<16;++r){const int orow=crow(r,hi);
      #pragma unroll
      for(int d0=0;d0<2;++d0)stg[orow*64+d0*32+r32]=__float2bfloat16(o[d0][r]*rli[r]);}
    asm volatile("s_waitcnt lgkmcnt(0)":::"memory");
    #pragma unroll
    for(int i=0;i<4;++i){const int row=i*8+(lane>>3),ch=lane&7; const u32x4 v=*(const u32x4*)(stg+row*64+ch*8); ATTN_STORE16(Ow+(long)row*OP+ch*8,v);} }
  asm volatile("s_waitcnt lgkmcnt(0)\n\ts_barrier":::"memory");
  #undef DMA_K
  #undef DMA_V
  #undef CMASK
  #undef INITB
  #undef INITB1
  #undef START
  #undef RESC
  #undef ROT
}
constexpr int ATTN_LDS_BYTES=LDS_BYTES;
struct AttnTensors { const bf16* Q; const bf16* K; const bf16* V; bf16* O; const float* cum; };
struct AttnUnit { int bh; int qb; };
struct StaticOrder {
  int vcu;
  __device__ __forceinline__ explicit StaticOrder(int vcu_):vcu(vcu_){}
  __device__ __forceinline__ bool next(int i,AttnUnit&u)const{ if(i>=2||vcu>=256)return false; const int s=vcu&3; u.bh=vcu>>2; u.qb=(i==0)?7-s:s; return true; }
  __device__ __forceinline__ void a_ready(const AttnUnit&)const{}
  __device__ __forceinline__ void done(const AttnUnit&)const{}
};
template<class Sched,int THRL=8> __device__ __forceinline__ void attn_phase(char*lds,const AttnTensors&T,const Sched&S){
  AttnUnit u;
  for(int i=0;S.next(i,u);++i){ S.a_ready(u); attn_unit<THRL>(u.bh/NHEAD,u.bh%NHEAD,u.qb,T.Q,T.K,T.V,T.O,T.cum+(long)u.bh*SEQ,lds); S.done(u); }
}
#undef SBAR
#undef WAIT_BAR
}
namespace cg = cooperative_groups;
#define LAS __attribute__((address_space(3)))
typedef unsigned short bf16_t;
typedef unsigned v4u __attribute__((ext_vector_type(4)));
typedef unsigned v2u __attribute__((ext_vector_type(2)));
typedef float f32x4 __attribute__((ext_vector_type(4)));
typedef short bf16x8 __attribute__((ext_vector_type(8)));
using pg8::pkbf; using pg8::bflo; using pg8::bfhi; using pg8::sigm;
constexpr int NWAVES = 8, NTHR = 512;
constexpr int T = 16384, DMODEL = 1024, SEQ = 2048, NB = 8, ZP = 5632, NIN = 5648, DFF = 2816;
constexpr float EPS = 1e-6f;
constexpr size_t MiB = 1u << 20;
constexpr size_t WS_RSTD1 = 64 * 1024, WS_RSS2 = 128 * 1024, WS_RSS3 = 192 * 1024, WS_MPREV = 256 * 1024;
constexpr size_t WS_GATES = 1 * MiB;
constexpr size_t WS_CUMF = 2 * MiB;
constexpr size_t WS_NPREV = 2 * MiB + 512 * 1024;
constexpr size_t WS_WIN = 3 * MiB, WS_WGU = 14 * MiB, WS_WD = 25 * MiB, WS_WBM = 31 * MiB, WS_WBF = 32 * MiB, WS_WOUT = 33 * MiB;
constexpr size_t WS_XB = 35 * MiB;
constexpr size_t WS_Z = 67 * MiB;
constexpr size_t WS_H = WS_Z;
constexpr size_t WS_X1B = WS_Z + 88 * MiB;
constexpr size_t WS_END = WS_Z + 176 * MiB;
constexpr size_t OUT_YM = 0, OUT_YF = 16 * MiB, OUT_CST = 32 * MiB;

constexpr int LDS_BYTES = 147456;
constexpr int MISC_OFF = 131072 + 320;
#define GAS __attribute__((address_space(1)))

struct Args { const float* in[15]; float* out; unsigned char* ws; int ph_lo, ph_hi; };

__device__ __forceinline__ float logsig(float v) { return fminf(v, 0.f) - log1pf(expf(-fabsf(v))); }
__device__ __forceinline__ float silu(float v) { return v / (1.0f + __expf(-v)); }

__device__ __forceinline__ void p0_transpose_item(const float* __restrict__ W, int ldw, int K, bf16_t* WT, int dest_row0, int src_col0, const float* __restrict__ kscale, LAS float* scr, int kb, int lane) {
    const int k0 = 32 * kb, nq = lane & 15, kr = lane >> 4;
    f32x4 v[8];
#pragma unroll
    for (int i = 0; i < 8; ++i) v[i] = *(const f32x4*)(W + (size_t)(k0 + 4 * i + kr) * ldw + src_col0 + 4 * nq);
#pragma unroll
    for (int i = 0; i < 8; ++i) { const int kk = 4 * i + kr; const float sc = kscale ? kscale[k0 + kk] : 1.f; LAS float* d = scr + kk * 65 + 4 * nq; d[0] = v[i][0] * sc; d[1] = v[i][1] * sc; d[2] = v[i][2] * sc; d[3] = v[i][3] * sc; }
    asm volatile("s_waitcnt lgkmcnt(0)" ::: "memory");
    const int c = lane & 3;
#pragma unroll
    for (int j = 0; j < 4; ++j) { const int n = (lane >> 2) + 16 * j; const LAS float* s = scr + (8 * c) * 65 + n;
        v4u o; o.x = pkbf(s[0 * 65], s[1 * 65]); o.y = pkbf(s[2 * 65], s[3 * 65]); o.z = pkbf(s[4 * 65], s[5 * 65]); o.w = pkbf(s[6 * 65], s[7 * 65]);
        *(v4u*)(WT + (size_t)(dest_row0 + n) * K + k0 + 8 * c) = o; }
    asm volatile("s_waitcnt lgkmcnt(0)" ::: "memory");
}
__device__ __forceinline__ void p0_row_group_half(const float* __restrict__ x, const float* __restrict__ g1, const float* __restrict__ w_in, bf16_t* xb, int grp, int kh, int lane, f32x4& acc, float& ss) {
    const int m = lane & 15, kq = lane >> 4, row0 = 16 * grp;
    const float* xr = x + (size_t)(row0 + m) * DMODEL + 512 * kh + 8 * kq;
    bf16_t* xo = xb + (size_t)(row0 + m) * DMODEL + 512 * kh + 8 * kq;
    const int gsrc = (m < 8) ? 2048 + m : 3584 + m;
    const float* wp = w_in + gsrc + (size_t)(512 * kh + 8 * kq) * NIN;
    const float* gp = g1 + 512 * kh + 8 * kq;
    acc = (f32x4){0.f, 0.f, 0.f, 0.f}; ss = 0.f;
#pragma unroll 4
    for (int it = 0; it < 16; ++it) {
        const f32x4 a0 = *(const f32x4*)(xr + 32 * it), a1 = *(const f32x4*)(xr + 32 * it + 4);
        const f32x4 s0 = *(const f32x4*)(gp + 32 * it), s1 = *(const f32x4*)(gp + 32 * it + 4);
        float bw[8];
#pragma unroll
        for (int i = 0; i < 8; ++i) bw[i] = wp[(size_t)(32 * it + i) * NIN];
        ss += (a0[0] * a0[0] + a0[1] * a0[1]) + (a0[2] * a0[2] + a0[3] * a0[3]) + (a1[0] * a1[0] + a1[1] * a1[1]) + (a1[2] * a1[2] + a1[3] * a1[3]);
        v4u o; o.x = pkbf(a0[0], a0[1]); o.y = pkbf(a0[2], a0[3]); o.z = pkbf(a1[0], a1[1]); o.w = pkbf(a1[2], a1[3]);
        *(v4u*)(xo + 32 * it) = o;
#pragma unroll
        for (int i = 0; i < 4; ++i) acc = __builtin_amdgcn_mfma_f32_16x16x4f32(a0[i], bw[i] * s0[i], acc, 0, 0, 0);
#pragma unroll
        for (int i = 0; i < 4; ++i) acc = __builtin_amdgcn_mfma_f32_16x16x4f32(a1[i], bw[4 + i] * s1[i], acc, 0, 0, 0);
    }
}
__device__ __forceinline__ void p0_row_group_finish(const float* __restrict__ b_in, float* rstd1, float* gates, int grp, int lane, f32x4 acc, float ss) {
    const int m = lane & 15, kq = lane >> 4, row0 = 16 * grp;
    ss += __shfl_xor(ss, 16); ss += __shfl_xor(ss, 32);
    const float rstd = rsqrtf(ss * (1.0f / DMODEL) + EPS);
    if (kq == 0) rstd1[row0 + m] = rstd;
    const float bias = b_in[(m < 8) ? 2048 + m : 3584 + m];
#pragma unroll
    for (int r = 0; r < 4; ++r) { const int rr = 4 * kq + r; const float rs = __shfl(rstd, rr); float v = acc[r] * rs + bias; if (m >= 4) v = logsig(v); gates[(size_t)(row0 + rr) * 16 + m] = v; }
}
__device__ __forceinline__ void fox_cumsum(const float* __restrict__ gates, float* cumf, int bh, int lane) {
    const int b = bh >> 3, h = bh & 7; const float* gp = gates + ((size_t)b * SEQ + 32 * lane) * 16 + 8 + h;
    float tot = 0.f;
#pragma unroll 8
    for (int j = 0; j < 32; ++j) tot += gp[j * 16];
    float incl = tot;
#pragma unroll
    for (int o = 1; o < 64; o <<= 1) { const float t = __shfl_up(incl, o); if (lane >= o) incl += t; }
    float run = incl - tot; float* cp = cumf + (size_t)bh * SEQ + 32 * lane;
#pragma unroll 8
    for (int j = 0; j < 32; ++j) { run += gp[j * 16]; cp[j] = run; }
}
__device__ __forceinline__ void conv8(const bf16_t* zrow, int tpos, const float* __restrict__ cw, const float* __restrict__ cb, int ch0, float (&o)[8]) {
    const f32x4 b0 = *(const f32x4*)(cb + ch0), b1 = *(const f32x4*)(cb + ch0 + 4);
    v4u r[4]; f32x4 w0[4], w1[4];
#pragma unroll
    for (int j = 0; j < 4; ++j) { const bool ok = (tpos - 3 + j) >= 0; r[j] = *(const v4u*)(zrow + (ok ? (long)(j - 3) * ZP : 0l)); w0[j] = *(const f32x4*)(cw + j * 1024 + ch0); w1[j] = *(const f32x4*)(cw + j * 1024 + ch0 + 4);
        if (!ok) { w0[j] = (f32x4){0.f, 0.f, 0.f, 0.f}; w1[j] = (f32x4){0.f, 0.f, 0.f, 0.f}; } }
    o[0] = b0[0]; o[1] = b0[1]; o[2] = b0[2]; o[3] = b0[3]; o[4] = b1[0]; o[5] = b1[1]; o[6] = b1[2]; o[7] = b1[3];
#pragma unroll
    for (int j = 0; j < 4; ++j) {
        o[0] += w0[j][0] * bflo(r[j].x); o[1] += w0[j][1] * bfhi(r[j].x); o[2] += w0[j][2] * bflo(r[j].y); o[3] += w0[j][3] * bfhi(r[j].y);
        o[4] += w1[j][0] * bflo(r[j].z); o[5] += w1[j][1] * bfhi(r[j].z); o[6] += w1[j][2] * bflo(r[j].w); o[7] += w1[j][3] * bfhi(r[j].w); }
#pragma unroll
    for (int i = 0; i < 8; ++i) o[i] = silu(o[i]);
}
__device__ __forceinline__ void chunk_gates(const float* __restrict__ gates, int b, int h, int c, int lane, float& bcum, float& g) {
    const float* gp = gates + ((size_t)b * SEQ + c * 64 + lane) * 16;
    const float ic = gp[h], fc = gp[4 + h];
    float incl = fc;
#pragma unroll
    for (int o = 1; o < 64; o <<= 1) { const float t = __shfl_up(incl, o); if (lane >= o) incl += t; }
    bcum = incl; g = ic - incl;
}
__device__ __forceinline__ float wave_max(float v) {
#pragma unroll
    for (int o = 1; o < 64; o <<= 1) v = fmaxf(v, __shfl_xor(v, o));
    return v;
}
constexpr int MS_KT = 0, MS_KT_BYTES = 16 * 72 * 2, MS_VT = 2 * MS_KT_BYTES, MS_VT_BYTES = 128 * 72 * 2, MS_W = MS_VT + 2 * MS_VT_BYTES, MS_TAB = MS_W + 2048 * 4;
struct MsRaw { v4u v0, v1, k0, k1, k2, k3; };
__device__ __forceinline__ void ms_load(MsRaw& r, const bf16_t* vsrc, const bf16_t* ksrc, int c, int ks, bool kthr) {
    r.v0 = *(const v4u*)(vsrc + (size_t)c * 64 * ZP); r.v1 = *(const v4u*)(vsrc + (size_t)c * 64 * ZP + 8);
    const v4u z = {0u, 0u, 0u, 0u}; r.k0 = z; r.k1 = z; r.k2 = z; r.k3 = z;
    if (kthr) { const bf16_t* kp = ksrc + (size_t)c * 64 * ZP; const int t = c * 64 + ks;
        if (t >= 3) r.k0 = *(const v4u*)(kp - 3 * (long)ZP); if (t >= 2) r.k1 = *(const v4u*)(kp - 2 * (long)ZP); if (t >= 1) r.k2 = *(const v4u*)(kp - (long)ZP); r.k3 = *(const v4u*)kp; }
}
__device__ __forceinline__ void ms_tap(float (&o)[8], const v4u r, const float (&w)[8]) {
    o[0] += w[0] * bflo(r.x); o[1] += w[1] * bfhi(r.x); o[2] += w[2] * bflo(r.y); o[3] += w[3] * bfhi(r.y); o[4] += w[4] * bflo(r.z); o[5] += w[5] * bfhi(r.z); o[6] += w[6] * bflo(r.w); o[7] += w[7] * bfhi(r.w);
}
__device__ __forceinline__ void mlstm_state_item(LAS unsigned char* lds, const bf16_t* __restrict__ Z, const float* __restrict__ gates, const float* __restrict__ conv_w, const float* __restrict__ conv_b,
                                                 bf16_t* CstT, float* nprev, float* mprev, int bh, int slice) {
    const int tid = threadIdx.x, lane = tid & 63, wave = __builtin_amdgcn_readfirstlane(tid >> 6);
    const int b = bh >> 2, h = bh & 3;
    const int vs = lane, vpart = wave;
    const int ks = lane, kdp = wave & 1; const bool kthr = tid < 128;
    const int kch = 512 + h * 128 + slice * 16 + 8 * kdp;
    const bf16_t* vsrc = Z + ((size_t)b * SEQ + vs) * ZP + 1024 + h * 128 + 16 * vpart;
    const bf16_t* ksrc = Z + ((size_t)b * SEQ + (kthr ? ks : 0)) * ZP + kch;
    LAS float* wT = (LAS float*)(lds + MS_W); LAS float* MxT = (LAS float*)(lds + MS_TAB); LAS float* blT = MxT + 32; LAS float* decT = MxT + 64; LAS float* mpT = MxT + 96; LAS float* M63T = MxT + 128;
    MsRaw A, B;
    ms_load(A, vsrc, ksrc, 0, ks, kthr); ms_load(B, vsrc, ksrc, 1, ks, kthr);
#pragma unroll
    for (int cc = 0; cc < 4; ++cc) { const int c = wave + 8 * cc; float bcum, g; chunk_gates(gates, b, h, c, lane, bcum, g); wT[c * 64 + lane] = g;
        const float mx = wave_max(g); if (lane == 63) { MxT[c] = mx; blT[c] = bcum; } }
    __syncthreads();
    if (tid == 0) { float m = 0.f; for (int c = 0; c < 32; ++c) { const float M63 = fmaxf(m, MxT[c]); decT[c] = expf(m - M63); mpT[c] = m; M63T[c] = M63; m = blT[c] + M63; } }
    __syncthreads();
    for (int i = tid; i < 2048; i += NTHR) wT[i] = expf(wT[i] - M63T[i >> 6]) * 0.08838834764831845f;
    if (slice == 0 && tid < 32) mprev[bh * 32 + tid] = mpT[tid];
    __syncthreads();
    float cw[4][8], cb[8];
#pragma unroll
    for (int i = 0; i < 8; ++i) { cb[i] = conv_b[kch + i];
#pragma unroll
        for (int j = 0; j < 4; ++j) cw[j][i] = conv_w[j * 1024 + kch + i]; }
    f32x4 acc = {0.f, 0.f, 0.f, 0.f}; float nst = 0.f;
#define MS_WRITE(R, c, buf) do { LAS bf16_t* kT_ = (LAS bf16_t*)(lds + MS_KT + (buf) * MS_KT_BYTES); LAS bf16_t* vT_ = (LAS bf16_t*)(lds + MS_VT + (buf) * MS_VT_BYTES); \
        { LAS bf16_t* d = vT_ + (16 * vpart) * 72 + vs; \
          d[0 * 72] = (bf16_t)(R.v0.x & 0xffff); d[1 * 72] = (bf16_t)(R.v0.x >> 16); d[2 * 72] = (bf16_t)(R.v0.y & 0xffff); d[3 * 72] = (bf16_t)(R.v0.y >> 16); \
          d[4 * 72] = (bf16_t)(R.v0.z & 0xffff); d[5 * 72] = (bf16_t)(R.v0.z >> 16); d[6 * 72] = (bf16_t)(R.v0.w & 0xffff); d[7 * 72] = (bf16_t)(R.v0.w >> 16); \
          d[8 * 72] = (bf16_t)(R.v1.x & 0xffff); d[9 * 72] = (bf16_t)(R.v1.x >> 16); d[10 * 72] = (bf16_t)(R.v1.y & 0xffff); d[11 * 72] = (bf16_t)(R.v1.y >> 16); \
          d[12 * 72] = (bf16_t)(R.v1.z & 0xffff); d[13 * 72] = (bf16_t)(R.v1.z >> 16); d[14 * 72] = (bf16_t)(R.v1.w & 0xffff); d[15 * 72] = (bf16_t)(R.v1.w >> 16); } \
        if (kthr) { float kv[8]; _Pragma("unroll") for (int i = 0; i < 8; ++i) kv[i] = cb[i]; \
            ms_tap(kv, R.k0, cw[0]); ms_tap(kv, R.k1, cw[1]); ms_tap(kv, R.k2, cw[2]); ms_tap(kv, R.k3, cw[3]); \
            const float ws_ = wT[(c) * 64 + ks]; LAS bf16_t* d = kT_ + (8 * kdp) * 72 + ks; \
            _Pragma("unroll") for (int i = 0; i < 8; i += 2) { const unsigned p = pkbf(silu(kv[i]) * ws_, silu(kv[i + 1]) * ws_); d[i * 72] = (bf16_t)(p & 0xffff); d[(i + 1) * 72] = (bf16_t)(p >> 16); } } } while (0)
#define MS_COMPUTE(c, buf) do { const LAS bf16_t* kT_ = (const LAS bf16_t*)(lds + MS_KT + (buf) * MS_KT_BYTES); const LAS bf16_t* vT_ = (const LAS bf16_t*)(lds + MS_VT + (buf) * MS_VT_BYTES); \
        const bf16x8 a0 = *(const LAS bf16x8*)(kT_ + (lane & 15) * 72 + 8 * (lane >> 4)), a1 = *(const LAS bf16x8*)(kT_ + (lane & 15) * 72 + 32 + 8 * (lane >> 4)); \
        const bf16x8 b0 = *(const LAS bf16x8*)(vT_ + (16 * wave + (lane & 15)) * 72 + 8 * (lane >> 4)), b1 = *(const LAS bf16x8*)(vT_ + (16 * wave + (lane & 15)) * 72 + 32 + 8 * (lane >> 4)); \
        const float decay = decT[c]; \
        { const int dv = 16 * wave + (lane & 15), dk0 = slice * 16 + 4 * (lane >> 4); v2u o; o.x = pkbf(acc[0], acc[1]); o.y = pkbf(acc[2], acc[3]); \
          *(v2u*)(CstT + ((size_t)(bh * 32 + (c)) * 128 + dv) * 128 + dk0) = o; \
          if (wave == 0 && lane < 16) nprev[(size_t)(bh * 32 + (c)) * 128 + slice * 16 + lane] = nst; } \
        acc = acc * decay; \
        acc = __builtin_amdgcn_mfma_f32_16x16x32_bf16(a0, b0, acc, 0, 0, 0); acc = __builtin_amdgcn_mfma_f32_16x16x32_bf16(a1, b1, acc, 0, 0, 0); \
        float ps = 0.f; _Pragma("unroll") for (int i = 0; i < 8; ++i) ps += __uint_as_float((unsigned)(unsigned short)a0[i] << 16) + __uint_as_float((unsigned)(unsigned short)a1[i] << 16); \
        ps += __shfl_xor(ps, 16); ps += __shfl_xor(ps, 32); nst = decay * nst + ps; } while (0)
    MS_WRITE(A, 0, 0); ms_load(A, vsrc, ksrc, 2, ks, kthr);
    for (int c = 0; c < 32; c += 2) {
        __syncthreads();
        MS_COMPUTE(c, 0);
        MS_WRITE(B, c + 1, 1); if (c + 3 < 32) ms_load(B, vsrc, ksrc, c + 3, ks, kthr);
        __syncthreads();
        MS_COMPUTE(c + 1, 1);
        if (c + 2 < 32) { MS_WRITE(A, c + 2, 0); if (c + 4 < 32) ms_load(A, vsrc, ksrc, c + 4, ks, kthr); }
    }
#undef MS_WRITE
#undef MS_COMPUTE
    __syncthreads();
}
constexpr int MO_QS = 0, MO_KS = 64 * 136 * 2, MO_VT = 2 * 64 * 136 * 2, MO_SP = MO_VT + 128 * 72 * 2, MO_TAB = MO_SP + 64 * 72 * 2, MO_CW = MO_TAB + 4096;
__device__ __forceinline__ void mlstm_out_item(LAS unsigned char* lds, const bf16_t* __restrict__ Z, const float* __restrict__ gates, const float* __restrict__ conv_w, const float* __restrict__ conv_b,
                                               const float* __restrict__ gnorm, const bf16_t* __restrict__ CstT, const float* __restrict__ nprev, const float* __restrict__ mprev, bf16_t* ym, int bh, int c) {
    const int tid = threadIdx.x, lane = tid & 63, wave = __builtin_amdgcn_readfirstlane(tid >> 6);
    const int b = bh >> 2, h = bh & 3, chunk = bh * 32 + c;
    LAS bf16_t* qs = (LAS bf16_t*)(lds + MO_QS); LAS bf16_t* ksm = (LAS bf16_t*)(lds + MO_KS); LAS bf16_t* vT = (LAS bf16_t*)(lds + MO_VT); LAS bf16_t* Sp = (LAS bf16_t*)(lds + MO_SP);
    LAS float* gT = (LAS float*)(lds + MO_TAB); LAS float* MT = gT + 64; LAS float* aT = gT + 128; LAS float* emT = gT + 192; LAS float* denT = gT + 256; LAS float* ssqT = gT + 320;
    const LAS float* cwT = (const LAS float*)(lds + MO_CW);
    const float m_prev = mprev[chunk];
    const int s = tid >> 3, part = tid & 7; const size_t zrow = ((size_t)b * SEQ + c * 64 + s) * ZP;
    f32x4 npv[4];
    { const float* np = nprev + (size_t)chunk * 128 + 16 * part;
#pragma unroll
      for (int k = 0; k < 4; ++k) npv[k] = *(const f32x4*)(np + 4 * k); }
    const int dvg = h * 128 + 16 * wave + (lane & 15); const float gn = gnorm[dvg];
    v4u rq[2][4], rk[2][4], rv[2]; bf16x8 cf[4];
    { const int tpos = c * 64 + s;
#pragma unroll
      for (int hh = 0; hh < 2; ++hh)
#pragma unroll
        for (int j = 0; j < 4; ++j) { const long ro = (tpos - 3 + j >= 0) ? (long)(j - 3) * ZP : 0l; const bf16_t* p = Z + zrow + ro + h * 128 + 16 * part + 8 * hh; rq[hh][j] = *(const v4u*)p; rk[hh][j] = *(const v4u*)(p + 512); }
      const int vsl = lane; const bf16_t* vsrc = Z + ((size_t)b * SEQ + c * 64 + vsl) * ZP + 1024 + h * 128 + 16 * wave; rv[0] = *(const v4u*)vsrc; rv[1] = *(const v4u*)(vsrc + 8);
      const bf16_t* cp = CstT + ((size_t)chunk * 128 + 16 * wave + (lane & 15)) * 128 + 8 * (lane >> 4);
#pragma unroll
      for (int k = 0; k < 4; ++k) cf[k] = *(const bf16x8*)(cp + 32 * k); }
    __builtin_amdgcn_sched_barrier(0);
    if (wave == 0) { float bcum, g; chunk_gates(gates, b, h, c, lane, bcum, g);
        float pm = g;
#pragma unroll
        for (int o = 1; o < 64; o <<= 1) { const float t = __shfl_up(pm, o); if (lane >= o) pm = fmaxf(pm, t); }
        const float Mt = fmaxf(m_prev, pm);
        gT[lane] = g; MT[lane] = Mt; aT[lane] = expf(m_prev - Mt); emT[lane] = expf(-(bcum + Mt)); }
    { const int tpos = c * 64 + s;
#pragma unroll
      for (int isk = 0; isk < 2; ++isk)
#pragma unroll
        for (int hh = 0; hh < 2; ++hh) { const int ci = isk * 128 + 16 * part + 8 * hh; float o[8];
            { const f32x4 b0 = *(const LAS f32x4*)(cwT + 4 * 256 + ci), b1 = *(const LAS f32x4*)(cwT + 4 * 256 + ci + 4); o[0] = b0[0]; o[1] = b0[1]; o[2] = b0[2]; o[3] = b0[3]; o[4] = b1[0]; o[5] = b1[1]; o[6] = b1[2]; o[7] = b1[3]; }
#pragma unroll
            for (int j = 0; j < 4; ++j) { const float ok = (tpos - 3 + j >= 0) ? 1.f : 0.f; const f32x4 w0 = *(const LAS f32x4*)(cwT + j * 256 + ci) * ok, w1 = *(const LAS f32x4*)(cwT + j * 256 + ci + 4) * ok; const v4u r = isk ? rk[hh][j] : rq[hh][j];
                o[0] += w0[0] * bflo(r.x); o[1] += w0[1] * bfhi(r.x); o[2] += w0[2] * bflo(r.y); o[3] += w0[3] * bfhi(r.y); o[4] += w1[0] * bflo(r.z); o[5] += w1[1] * bfhi(r.z); o[6] += w1[2] * bflo(r.w); o[7] += w1[3] * bfhi(r.w); }
            const float sc = isk ? 0.08838834764831845f : 1.f;
#pragma unroll
            for (int i = 0; i < 8; ++i) o[i] = silu(o[i]) * sc;
            v4u w; w.x = pkbf(o[0], o[1]); w.y = pkbf(o[2], o[3]); w.z = pkbf(o[4], o[5]); w.w = pkbf(o[6], o[7]); *(LAS v4u*)((isk ? ksm : qs) + s * 136 + 16 * part + 8 * hh) = w; }
      LAS bf16_t* d = vT + (16 * wave) * 72 + lane; const v4u r0 = rv[0], r1 = rv[1];
      d[0 * 72] = (bf16_t)(r0.x & 0xffff); d[1 * 72] = (bf16_t)(r0.x >> 16); d[2 * 72] = (bf16_t)(r0.y & 0xffff); d[3 * 72] = (bf16_t)(r0.y >> 16);
      d[4 * 72] = (bf16_t)(r0.z & 0xffff); d[5 * 72] = (bf16_t)(r0.z >> 16); d[6 * 72] = (bf16_t)(r0.w & 0xffff); d[7 * 72] = (bf16_t)(r0.w >> 16);
      d[8 * 72] = (bf16_t)(r1.x & 0xffff); d[9 * 72] = (bf16_t)(r1.x >> 16); d[10 * 72] = (bf16_t)(r1.y & 0xffff); d[11 * 72] = (bf16_t)(r1.y >> 16);
      d[12 * 72] = (bf16_t)(r1.z & 0xffff); d[13 * 72] = (bf16_t)(r1.z >> 16); d[14 * 72] = (bf16_t)(r1.w & 0xffff); d[15 * 72] = (bf16_t)(r1.w >> 16); }
    __syncthreads();
    { const int mt = wave >> 1;
#pragma unroll
      for (int j = 0; j < 2; ++j) { const int nt = 2 * (wave & 1) + j; f32x4 sa = {0.f, 0.f, 0.f, 0.f};
#pragma unroll
        for (int k = 0; k < 4; ++k) { const bf16x8 a = *(const LAS bf16x8*)(qs + (16 * mt + (lane & 15)) * 136 + 32 * k + 8 * (lane >> 4)), bb = *(const LAS bf16x8*)(ksm + (16 * nt + (lane & 15)) * 136 + 32 * k + 8 * (lane >> 4));
            sa = __builtin_amdgcn_mfma_f32_16x16x32_bf16(a, bb, sa, 0, 0, 0); }
        const int sc = 16 * nt + (lane & 15); const float gs = gT[sc];
#pragma unroll
        for (int i = 0; i < 4; ++i) { const int tr = 16 * mt + 4 * (lane >> 4) + i; const float v = (sc <= tr) ? sa[i] * expf(gs - MT[tr]) : 0.f;
            Sp[tr * 72 + sc] = (bf16_t)(pkbf(v, 0.f) & 0xffff); } } }
    __syncthreads();
    { const v4u r = *(const LAS v4u*)(Sp + s * 72 + 8 * part);
      float ds = (bflo(r.x) + bfhi(r.x)) + (bflo(r.y) + bfhi(r.y)) + (bflo(r.z) + bfhi(r.z)) + (bflo(r.w) + bfhi(r.w));
      float qn = 0.f;
#pragma unroll
      for (int hh = 0; hh < 2; ++hh) { const v4u q = *(const LAS v4u*)(qs + s * 136 + 16 * part + 8 * hh); const f32x4 n0 = npv[2 * hh], n1 = npv[2 * hh + 1];
          qn += bflo(q.x) * n0[0] + bfhi(q.x) * n0[1] + bflo(q.y) * n0[2] + bfhi(q.y) * n0[3] + bflo(q.z) * n1[0] + bfhi(q.z) * n1[1] + bflo(q.w) * n1[2] + bfhi(q.w) * n1[3]; }
      ds += __shfl_xor(ds, 1); ds += __shfl_xor(ds, 2); ds += __shfl_xor(ds, 4);
      qn += __shfl_xor(qn, 1); qn += __shfl_xor(qn, 2); qn += __shfl_xor(qn, 4);
      if (part == 0) denT[s] = fmaxf(fabsf(aT[s] * qn + ds), emT[s]); }
    f32x4 num[4];
#pragma unroll
    for (int mt = 0; mt < 4; ++mt) { f32x4 a4 = {0.f, 0.f, 0.f, 0.f};
#pragma unroll
        for (int k = 0; k < 4; ++k) { const bf16x8 a = *(const LAS bf16x8*)(qs + (16 * mt + (lane & 15)) * 136 + 32 * k + 8 * (lane >> 4)); a4 = __builtin_amdgcn_mfma_f32_16x16x32_bf16(a, cf[k], a4, 0, 0, 0); }
#pragma unroll
        for (int i = 0; i < 4; ++i) a4[i] *= aT[16 * mt + 4 * (lane >> 4) + i];
#pragma unroll
        for (int k = 0; k < 2; ++k) { const bf16x8 a = *(const LAS bf16x8*)(Sp + (16 * mt + (lane & 15)) * 72 + 32 * k + 8 * (lane >> 4)), bb = *(const LAS bf16x8*)(vT + (16 * wave + (lane & 15)) * 72 + 32 * k + 8 * (lane >> 4));
            a4 = __builtin_amdgcn_mfma_f32_16x16x32_bf16(a, bb, a4, 0, 0, 0); }
        num[mt] = a4; }
    __syncthreads();
#pragma unroll
    for (int mt = 0; mt < 4; ++mt)
#pragma unroll
        for (int i = 0; i < 4; ++i) { const int tr = 16 * mt + 4 * (lane >> 4) + i; const float hv = num[mt][i] / denT[tr]; num[mt][i] = hv;
            float q = hv * hv; q += __shfl_xor(q, 1); q += __shfl_xor(q, 2); q += __shfl_xor(q, 4); q += __shfl_xor(q, 8);
            if ((lane & 15) == 0) ssqT[wave * 64 + tr] = q; }
    __syncthreads();
    { const int dv = dvg;
#pragma unroll
      for (int mt = 0; mt < 4; ++mt)
#pragma unroll
        for (int i = 0; i < 4; ++i) { const int tr = 16 * mt + 4 * (lane >> 4) + i; float tot = 0.f;
#pragma unroll
            for (int w8 = 0; w8 < 8; ++w8) tot += ssqT[w8 * 64 + tr];
            const size_t row = (size_t)b * SEQ + c * 64 + tr; const float mo = __uint_as_float((unsigned)Z[row * ZP + 1536 + dv] << 16);
            const float y = num[mt][i] * rsqrtf(tot * (1.0f / 128.0f) + EPS) * gn * sigm(mo);
            ym[row * 512 + dv] = (bf16_t)(pkbf(y, 0.f) & 0xffff); } }
}
#define XB_TMO      128
#define XB_XCNT(j)  (256  + 64 * (j))
#define XB_XSUB(j)  (1280 + 64 * (j))
#define XB_XGEN(j)  (2304 + 64 * (j))
#define XB_TOP      3328
#define XB_TOPGEN   3392
#define XCD_BAR_WORDS 3456
#define XB_SPIN_CAP (1u << 18)

__device__ __forceinline__ unsigned xb_ld(unsigned* p)              { return __hip_atomic_load(p, __ATOMIC_RELAXED, __HIP_MEMORY_SCOPE_AGENT); }
__device__ __forceinline__ unsigned xb_add(unsigned* p, unsigned v) { return __hip_atomic_fetch_add(p, v, __ATOMIC_RELAXED, __HIP_MEMORY_SCOPE_AGENT); }
__device__ __forceinline__ unsigned xb_xcc_id() { return (unsigned)__builtin_amdgcn_s_getreg((3 << 11) | 20) & 0xFu; }
#define XB_SPIN(cond, bar) do { unsigned _sp = 0; while (cond) { __builtin_amdgcn_s_sleep(1); \
    if ((++_sp & 255u) == 0u) { if (xb_ld(&(bar)[XB_TMO])) break; if (_sp > XB_SPIN_CAP) { atomicAdd(&(bar)[XB_TMO], 1u); break; } } } } while (0)

struct XcdBarrier {
    unsigned* bar; unsigned x;
    volatile LAS unsigned* st;
};

__device__ __forceinline__ XcdBarrier xcd_barrier_post(unsigned* bar, volatile LAS unsigned* st) {
    XcdBarrier b; b.bar = bar; b.x = xb_xcc_id(); b.st = st;
    if (threadIdx.x == 0) (void)xb_add(&bar[XB_XCNT(b.x)], 1u);
    return b;
}
__device__ __forceinline__ void xcd_barrier_complete(unsigned* bar, unsigned x, unsigned& nloc, unsigned& nx) {
    const unsigned G = gridDim.x * gridDim.y * gridDim.z;
    unsigned sum, cnt, mine, sp = 0u;
    for (;;) {
        sum = 0u; cnt = 0u; mine = 0u;
#pragma unroll
        for (unsigned j = 0; j < 16; ++j) { const unsigned c = xb_ld(&bar[XB_XCNT(j)]); sum += c; cnt += (c > 0u) ? 1u : 0u; mine = (j == x) ? c : mine; }
        if (sum == G) break;
        __builtin_amdgcn_s_sleep(1);
        if ((++sp & 255u) == 0u) { if (xb_ld(&bar[XB_TMO])) break; if (sp > XB_SPIN_CAP) { atomicAdd(&bar[XB_TMO], 1u); break; } }
    }
    nloc = mine > 0u ? mine : 1u; nx = cnt > 0u ? cnt : 1u;
}

__device__ __forceinline__ void xcd_barrier(const XcdBarrier& b) {
    asm volatile("s_waitcnt vmcnt(0)" ::: "memory");
    __syncthreads();
    if (threadIdx.x == 0) {
        unsigned* bar = b.bar;
        __builtin_amdgcn_s_waitcnt(0);
        unsigned nloc = b.st[0], nx = b.st[1];
        if (nloc == 0u) { xcd_barrier_complete(bar, b.x, nloc, nx); b.st[0] = nloc; b.st[1] = nx; }
        const unsigned old = xb_add(&bar[XB_XSUB(b.x)], 1u);
        const unsigned gen = old / nloc;
        if (old + 1u == (gen + 1u) * nloc) {
            __builtin_amdgcn_fence(__ATOMIC_RELEASE, "agent");
            asm volatile("s_waitcnt vmcnt(0)" ::: "memory");
            const unsigned og = xb_add(&bar[XB_TOP], 1u);
            const unsigned tg = og / nx;
            if (og + 1u == (tg + 1u) * nx) xb_add(&bar[XB_TOPGEN], 1u);
            else XB_SPIN(xb_ld(&bar[XB_TOPGEN]) == tg, bar);
            __builtin_amdgcn_fence(__ATOMIC_ACQUIRE, "agent");
            xb_add(&bar[XB_XGEN(b.x)], 1u);
            asm volatile("s_waitcnt vmcnt(0)" ::: "memory");
        } else {
            XB_SPIN(xb_ld(&bar[XB_XGEN(b.x)]) == gen, bar);
            __builtin_amdgcn_fence(__ATOMIC_ACQUIRE, "agent");
            asm volatile("s_waitcnt vmcnt(0)" ::: "memory");
        }
    }
    __syncthreads();
}
__global__ void __launch_bounds__(NTHR, 2) fwd_mega(Args args) {
    extern __shared__ __attribute__((aligned(16))) unsigned char lds_raw[];
    LAS unsigned char* lds = (LAS unsigned char*)lds_raw;
    cg::grid_group grid = cg::this_grid();
    const int tid = threadIdx.x, lane = tid & 63, wave = __builtin_amdgcn_readfirstlane(tid >> 6);
    const int G = gridDim.x, bx = blockIdx.x;
    const int vcu = (G % 8 == 0) ? (bx % 8) * (G / 8) + bx / 8 : bx;
    const int gw = vcu * NWAVES + wave, NGW = G * NWAVES;
    unsigned char* ws = args.ws;
    const float* x = args.in[0]; const float* norm1_g = args.in[1]; const float* w_in = args.in[2]; const float* b_in = args.in[3];
    const float* conv_w = args.in[4]; const float* conv_b = args.in[5]; const float* mnorm_g = args.in[6]; const float* w_brm = args.in[7]; const float* w_brf = args.in[8];
    const float* w_out = args.in[9]; const float* norm2_g = args.in[10]; const float* w_gate = args.in[11]; const float* w_up = args.in[12]; const float* w_down = args.in[13]; const float* normf_g = args.in[14];
    float* out = args.out;
    float* rstd1 = (float*)(ws + WS_RSTD1); float* rss2 = (float*)(ws + WS_RSS2); float* rss3 = (float*)(ws + WS_RSS3); float* mprev = (float*)(ws + WS_MPREV);
    float* gates = (float*)(ws + WS_GATES); float* cumf = (float*)(ws + WS_CUMF); float* nprev = (float*)(ws + WS_NPREV);
    bf16_t* WinT = (bf16_t*)(ws + WS_WIN); bf16_t* WguT = (bf16_t*)(ws + WS_WGU); bf16_t* WdT = (bf16_t*)(ws + WS_WD); bf16_t* WbmT = (bf16_t*)(ws + WS_WBM); bf16_t* WbfT = (bf16_t*)(ws + WS_WBF); bf16_t* WoutT = (bf16_t*)(ws + WS_WOUT);
    bf16_t* XB = (bf16_t*)(ws + WS_XB); bf16_t* MIX = XB; bf16_t* Z = (bf16_t*)(ws + WS_Z); bf16_t* HB = (bf16_t*)(ws + WS_H); bf16_t* X1B = (bf16_t*)(ws + WS_X1B);
    bf16_t* YM = (bf16_t*)((unsigned char*)out + OUT_YM); bf16_t* YF = (bf16_t*)((unsigned char*)out + OUT_YF); bf16_t* CstT = (bf16_t*)((unsigned char*)out + OUT_CST);
    const int lo = args.ph_lo, hi = args.ph_hi;
#ifndef PROBE_DUP
#define PROBE_DUP 0
#endif
#define IN(k) (lo <= (k) && (k) < hi)
#define REP(k) for (int rep_ = 0; rep_ < 1 + ((PROBE_DUP >> (k)) & 1); ++rep_)
#define SEAM(k) do { if (IN(k) && IN((k) + 1)) { xcd_barrier(bar); if (PROBE_DUP & 256) xcd_barrier(bar); } } while (0)
    if (tid < 32) ((LAS unsigned*)(lds + MISC_OFF))[tid] = 0u;
    __syncthreads();
    XcdBarrier bar = xcd_barrier_post((unsigned*)ws, (volatile LAS unsigned*)(lds + MISC_OFF) + 8);
    if (hi - lo > 1) { grid.sync(); if (PROBE_DUP & 512) grid.sync(); }

    if (IN(0)) {
        for (int i = bx * NTHR + tid; i < T; i += G * NTHR) { rss2[i] = 0.f; rss3[i] = 0.f; }
        for (int g0 = vcu * 4; g0 < T / 16; g0 += G * 4) {
            const int grp = g0 + (wave & 3), kh = wave >> 2; f32x4 acc; float ss;
            p0_row_group_half(x, norm1_g, w_in, XB, grp, kh, lane, acc, ss);
            LAS float* ex = (LAS float*)(lds + 8 * 8448) + ((wave & 3) * 64 + lane) * 5;
            if (kh == 1) { ex[0] = acc[0]; ex[1] = acc[1]; ex[2] = acc[2]; ex[3] = acc[3]; ex[4] = ss; }
            __syncthreads();
            if (kh == 0) { acc[0] += ex[0]; acc[1] += ex[1]; acc[2] += ex[2]; acc[3] += ex[3]; ss += ex[4]; p0_row_group_finish(b_in, rstd1, gates, grp, lane, acc, ss); }
            __syncthreads();
        }
        LAS float* scr = (LAS float*)(lds + wave * 8448);
        constexpr int I_IN = 32 * 88, I_GU = 32 * 88, I_D = 88 * 16, I_BM = 16 * 16, I_BF = 16 * 16, I_O = 32 * 16;
        constexpr int NITEMS = I_IN + I_GU + I_D + I_BM + I_BF + I_O;
        for (int it = gw; it < NITEMS; it += NGW) {
            int r = it;
            if (r < I_IN) { const int kb = r / 88, nb = r % 88, d0 = 64 * nb; const int s0 = d0 + (d0 >= 2048 ? 8 : 0) + (d0 >= 3584 ? 8 : 0);
                p0_transpose_item(w_in, NIN, 1024, WinT, d0, s0, norm1_g, scr, kb, lane); continue; } r -= I_IN;
            if (r < I_GU) { const int kb = r / 88, nb = r % 88, d0 = 64 * nb; const int tile = d0 >> 8, within = d0 & 255; const int j0 = tile * 128 + (within & 127);
                p0_transpose_item((within < 128) ? w_gate : w_up, DFF, 1024, WguT, d0, j0, norm2_g, scr, kb, lane); continue; } r -= I_GU;
            if (r < I_D) { const int kb = r / 16, nb = r % 16; p0_transpose_item(w_down, 1024, DFF, WdT, 64 * nb, 64 * nb, nullptr, scr, kb, lane); continue; } r -= I_D;
            if (r < I_BM) { const int kb = r / 16, nb = r % 16; p0_transpose_item(w_brm, 1024, 512, WbmT, 64 * nb, 64 * nb, nullptr, scr, kb, lane); continue; } r -= I_BM;
            if (r < I_BF) { const int kb = r / 16, nb = r % 16; p0_transpose_item(w_brf, 1024, 512, WbfT, 64 * nb, 64 * nb, nullptr, scr, kb, lane); continue; } r -= I_BF;
            { const int kb = r / 16, nb = r % 16; p0_transpose_item(w_out, 1024, 1024, WoutT, 64 * nb, 64 * nb, nullptr, scr, kb, lane); }
        }
    }
    SEAM(0);
    if (IN(1)) {
        if (wave == 0 && vcu < 64) fox_cumsum(gates, cumf, vcu, lane);
        pg8::Gemm g{XB, WinT, T, ZP, 1024}; pg8::StaticOrder S; S.init(T, ZP, G, bx);
        pg8::EpiInProj E{Z, rstd1, b_in};
        pg8::gemm_phase<pg8::EpiInProj, pg8::StaticOrder, true, true>(lds, g, S, E);
        if (PROBE_DUP & 2) pg8::gemm_phase<pg8::EpiInProj, pg8::StaticOrder, true, true>(lds, g, S, E);
    }
    SEAM(1);
    if (IN(2)) {
        const attn_body::AttnTensors AT{(const attn_body::bf16*)(Z + 2048), (const attn_body::bf16*)(Z + 2560), (const attn_body::bf16*)(Z + 3072), (attn_body::bf16*)YF, cumf};
        const attn_body::StaticOrder S(vcu);
        attn_body::attn_phase<attn_body::StaticOrder>((char*)lds_raw, AT, S);
        __syncthreads();
        for (int it = vcu; it < 256; it += G) mlstm_state_item(lds, Z, gates, conv_w, conv_b, CstT, nprev, mprev, it >> 3, it & 7);
            if (PROBE_DUP & 4) { attn_body::attn_phase<attn_body::StaticOrder>((char*)lds_raw, AT, S); __syncthreads(); for (int it = vcu; it < 256; it += G) mlstm_state_item(lds, Z, gates, conv_w, conv_b, CstT, nprev, mprev, it >> 3, it & 7); }
    }
    SEAM(2);
    if (IN(3)) {
        for (int it = vcu * 4; it < 1024; it += G * 4) {
            { const int hq = ((it >> 5) & 3) * 128; LAS float* cwT = (LAS float*)(lds + MO_CW);
              for (int i = tid; i < 5 * 256; i += NTHR) { const int j = i >> 8, ci = i & 255, ch = (ci < 128) ? hq + ci : 512 + hq + (ci - 128); cwT[i] = (j < 4) ? conv_w[j * 1024 + ch] : conv_b[ch]; }
              __syncthreads(); }
            for (int j = 0; j < 4; ++j) mlstm_out_item(lds, Z, gates, conv_w, conv_b, mnorm_g, CstT, nprev, mprev, YM, (it + j) >> 5, (it + j) & 31);
        if (PROBE_DUP & 8) for (int it = vcu * 4; it < 1024; it += G * 4)
            for (int j = 0; j < 4; ++j) mlstm_out_item(lds, Z, gates, conv_w, conv_b, mnorm_g, CstT, nprev, mprev, YM, (it + j) >> 5, (it + j) & 31);
            __syncthreads(); }
    }
    SEAM(3);
    if (IN(4)) {
        pg8::StaticOrder S; S.init(T, 1024, G, bx);
        { pg8::Gemm g{YM, WbmT, T, 1024, 512}; pg8::EpiBranch<0> E{MIX, Z}; pg8::gemm_phase<pg8::EpiBranch<0>, pg8::StaticOrder, true, true>(lds, g, S, E); }
        { pg8::Gemm g{YF, WbfT, T, 1024, 512}; pg8::EpiBranch<1> E{MIX, Z}; pg8::gemm_phase<pg8::EpiBranch<1>, pg8::StaticOrder, true, true>(lds, g, S, E); }
        if (PROBE_DUP & 16) {
        { pg8::Gemm g{YM, WbmT, T, 1024, 512}; pg8::EpiBranch<0> E{MIX, Z}; pg8::gemm_phase<pg8::EpiBranch<0>, pg8::StaticOrder, true, true>(lds, g, S, E); }
        { pg8::Gemm g{YF, WbfT, T, 1024, 512}; pg8::EpiBranch<1> E{MIX, Z}; pg8::gemm_phase<pg8::EpiBranch<1>, pg8::StaticOrder, true, true>(lds, g, S, E); }
        }
    }
    SEAM(4);
    if (IN(5)) {
        pg8::Gemm g{MIX, WoutT, T, 1024, 1024}; pg8::StaticOrder S; S.init(T, 1024, G, bx);
        pg8::EpiResid E{x, out, X1B, rss2};
        pg8::gemm_phase<pg8::EpiResid, pg8::StaticOrder, true, true>(lds, g, S, E);
    }
    SEAM(5);
    if (IN(6)) {
        pg8::Gemm g{X1B, WguT, T, 2 * DFF, 1024}; pg8::StaticOrder S; S.init(T, 2 * DFF, G, bx);
        pg8::EpiSwiglu E{HB, rss2};
        pg8::gemm_phase<pg8::EpiSwiglu, pg8::StaticOrder, true, true>(lds, g, S, E);
        if (PROBE_DUP & 64) pg8::gemm_phase<pg8::EpiSwiglu, pg8::StaticOrder, true, true>(lds, g, S, E);
    }
    SEAM(6);
    if (IN(7)) {
        pg8::Gemm g{HB, WdT, T, 1024, DFF}; pg8::StaticOrder S; S.init(T, 1024, G, bx);
        pg8::EpiResid E{out, out, nullptr, rss3};
        pg8::gemm_phase<pg8::EpiResid, pg8::StaticOrder, true, true>(lds, g, S, E);
    }
    SEAM(7);
    if (IN(8)) {
        f32x4 gv[4];
#pragma unroll
        for (int j = 0; j < 4; ++j) gv[j] = *(const f32x4*)(normf_g + 256 * j + 4 * lane);
        for (int m = gw; m < T; m += NGW) { const float rs = rsqrtf(rss3[m] * (1.0f / DMODEL) + EPS); f32x4* o = (f32x4*)(out + (size_t)m * DMODEL) + lane;
#pragma unroll
            for (int j = 0; j < 4; ++j) o[64 * j] = o[64 * j] * rs * gv[j]; }
    }
#undef IN
#undef SEAM
}

#ifndef MK_SPLIT
#define MK_SPLIT 0
#endif
extern "C" void kernel_launch(void* const* d_in, const int* in_sizes, int n_in, void* d_out, int out_size, void* d_ws, size_t ws_size, hipStream_t stream) {
    static int grid = 0;
    if (grid == 0) {
        if (n_in != 15 || out_size != T * DMODEL || ws_size < WS_END) { fprintf(stderr, "kernel_launch: unexpected shapes (n_in %d out %d ws %zu)\n", n_in, out_size, ws_size); grid = -1; return; }
        int dev = 0, cus = 0, per_cu = 0;
        hipGetDevice(&dev); hipDeviceGetAttribute(&cus, hipDeviceAttributeMultiprocessorCount, dev);
        if (hipFuncSetAttribute((const void*)fwd_mega, hipFuncAttributeMaxDynamicSharedMemorySize, LDS_BYTES) != hipSuccess) { fprintf(stderr, "kernel_launch: hipFuncSetAttribute failed\n"); grid = -1; return; }
        if (hipOccupancyMaxActiveBlocksPerMultiprocessor(&per_cu, (const void*)fwd_mega, NTHR, LDS_BYTES) != hipSuccess || per_cu < 1) { fprintf(stderr, "kernel_launch: occupancy query says %d\n", per_cu); per_cu = 1; }
        (void)hipGetLastError();
        grid = cus * 1;
    }
    if (grid < 0) return;
    if (hipMemsetAsync(d_ws, 0, 16384, stream) != hipSuccess) { fprintf(stderr, "kernel_launch: memset failed\n"); return; }
    Args a{};
    for (int i = 0; i < 15; ++i) a.in[i] = (const float*)d_in[i];
    a.out = (float*)d_out; a.ws = (unsigned char*)d_ws;
#if MK_SPLIT
    for (int p = 0; p < 9; ++p) { a.ph_lo = p; a.ph_hi = p + 1; hipLaunchKernelGGL(fwd_mega, dim3(grid), dim3(NTHR), LDS_BYTES, stream, a); }
#else
    a.ph_lo = 0; a.ph_hi = 9;
    void* kargs[] = {&a};
    hipError_t e = hipLaunchCooperativeKernel((const void*)fwd_mega, dim3(grid), dim3(NTHR), kargs, LDS_BYTES, stream);
    if (e != hipSuccess) fprintf(stderr, "kernel_launch: cooperative launch failed: %s (grid %d)\n", hipGetErrorString(e), grid);
#endif
}
```
